# Optimizing an MI355X kernel written in HIP

```python
import math
import jax, jax.numpy as jnp
from jax import lax
import numpy as np

D_MODEL = 4096
BATCH = 2
SEQ = 8192
DEPTH = 2

MIX_WIDTH = D_MODEL
GROUP_WIDTH = MIX_WIDTH // 4
HEAD_DIM = 128
MOBA_HEADS = GROUP_WIDTH // HEAD_DIM
MOBA_BLOCK = 256
MOBA_TOPK = 3
MOBA_QCHUNK = 32
GDN_HEADS = GROUP_WIDTH // HEAD_DIM
GDN_CONV = 4
GDN_CHUNK = 64
SC_CONV = 3
SC_GROUPS = GROUP_WIDTH // HEAD_DIM
SWA_HEAD_DIM = 64
SWA_Q_HEADS = GROUP_WIDTH // SWA_HEAD_DIM
SWA_KV_HEADS = 2
SWA_WINDOW = 128
D_FF = -(-8 * D_MODEL // (3 * 256)) * 256
EPS = 1e-6

IN_SIZES = (
    GROUP_WIDTH, GROUP_WIDTH, GROUP_WIDTH,
    3 * GROUP_WIDTH, GDN_HEADS, GDN_HEADS, GROUP_WIDTH,
    GROUP_WIDTH, GROUP_WIDTH, GROUP_WIDTH,
    SWA_Q_HEADS * SWA_HEAD_DIM, SWA_KV_HEADS * SWA_HEAD_DIM, SWA_KV_HEADS * SWA_HEAD_DIM,
)
IN_WIDTH = sum(IN_SIZES)
SPLIT_POINTS = tuple(int(v) for v in np.cumsum(IN_SIZES)[:-1])

kernel_name = "hymba_style_moba_gdn_shortconv_swa_block"


def rmsnorm(x, g):
    xf = x.astype(jnp.float32)
    y = xf * lax.rsqrt(jnp.mean(xf * xf, axis=-1, keepdims=True) + EPS) * g.astype(jnp.float32)
    return y.astype(x.dtype)


def l2norm(x):
    xf = x.astype(jnp.float32)
    return xf * lax.rsqrt(jnp.sum(xf * xf, axis=-1, keepdims=True) + EPS)


def causal_conv(x, w):
    kw = w.shape[0]
    s = x.shape[1]
    xp = jnp.pad(x, ((0, 0), (kw - 1, 0), (0, 0)))
    out = xp[:, 0:s] * w[0]
    for i in range(1, kw):
        out = out + xp[:, i:i + s] * w[i]
    return out


def moba_attention(q, k, v):
    b, s, h, d = q.shape
    nb = -(-s // MOBA_BLOCK)
    pad = nb * MOBA_BLOCK - s
    qh = q.transpose(0, 2, 1, 3)
    kh = jnp.pad(k.transpose(0, 2, 1, 3), ((0, 0), (0, 0), (0, pad), (0, 0)))
    vh = jnp.pad(v.transpose(0, 2, 1, 3), ((0, 0), (0, 0), (0, pad), (0, 0)))
    kb = kh.reshape(b, h, nb, MOBA_BLOCK, d)
    vb = vh.reshape(b, h, nb, MOBA_BLOCK, d)
    kmean = jnp.mean(kb.astype(jnp.float32), axis=3)
    topk = min(MOBA_TOPK, nb - 1)
    scale = d ** -0.5
    bi = jnp.arange(b)[:, None, None, None]
    hi = jnp.arange(h)[None, :, None, None]
    neg = -jnp.inf

    def chunk(c):
        q0 = c * MOBA_QCHUNK
        qc = lax.dynamic_slice_in_dim(qh, q0, MOBA_QCHUNK, axis=2)
        qpos = q0 + jnp.arange(MOBA_QCHUNK)
        blk = q0 // MOBA_BLOCK
        k_own = lax.dynamic_slice_in_dim(kh, blk * MOBA_BLOCK, MOBA_BLOCK, axis=2)
        v_own = lax.dynamic_slice_in_dim(vh, blk * MOBA_BLOCK, MOBA_BLOCK, axis=2)
        kpos = blk * MOBA_BLOCK + jnp.arange(MOBA_BLOCK)
        s_own = jnp.einsum('bhqd,bhkd->bhqk', qc, k_own).astype(jnp.float32) * scale
        s_own = jnp.where(kpos[None, :] <= qpos[:, None], s_own, neg)
        if topk > 0:
            gate = jnp.einsum('bhqd,bhnd->bhqn', qc.astype(jnp.float32), kmean)
            gate = jnp.where(jnp.arange(nb) < blk, gate, neg)
            gval, gidx = lax.top_k(gate, topk)
            valid = jnp.isfinite(gval)
            k_sel = kb[bi, hi, gidx]
            v_sel = vb[bi, hi, gidx]
            s_sel = jnp.einsum('bhqd,bhqtkd->bhqtk', qc, k_sel).astype(jnp.float32) * scale
            s_sel = jnp.where(valid[..., None], s_sel, neg)
            s_sel = s_sel.reshape(b, h, MOBA_QCHUNK, topk * MOBA_BLOCK)
            p = jax.nn.softmax(jnp.concatenate([s_sel, s_own], axis=-1), axis=-1)
            p_sel = p[..., :topk * MOBA_BLOCK].reshape(b, h, MOBA_QCHUNK, topk, MOBA_BLOCK)
            p_own = p[..., topk * MOBA_BLOCK:]
            o = (jnp.einsum('bhqtk,bhqtkd->bhqd', p_sel.astype(v.dtype), v_sel)
                 + jnp.einsum('bhqk,bhkd->bhqd', p_own.astype(v.dtype), v_own))
        else:
            p = jax.nn.softmax(s_own, axis=-1)
            o = jnp.einsum('bhqk,bhkd->bhqd', p.astype(v.dtype), v_own)
        return o.astype(q.dtype)

    out = lax.map(chunk, jnp.arange(s // MOBA_QCHUNK))
    return out.transpose(1, 0, 3, 2, 4).reshape(b, s, h * d)


def gated_delta_rule(q, k, v, g, beta):
    b, s, h, dk = q.shape
    dv = v.shape[-1]
    C = GDN_CHUNK
    nc = s // C
    f32 = jnp.float32

    def heads_chunks(t):
        t = jnp.moveaxis(t.astype(f32), 2, 1)
        return t.reshape((b, h, nc, C) + t.shape[3:])

    qc = heads_chunks(q) * (dk ** -0.5)
    kc = heads_chunks(k)
    vc = heads_chunks(v)
    gc = heads_chunks(g)
    bc = heads_chunks(beta)
    G = jnp.cumsum(gc, axis=-1)
    idx = jnp.arange(C)
    tril = idx[:, None] >= idx[None, :]
    strict = idx[:, None] > idx[None, :]
    decay = jnp.exp(jnp.where(tril, G[..., :, None] - G[..., None, :], -jnp.inf))
    k_beta = kc * bc[..., None]
    v_beta = vc * bc[..., None]
    kkt = jnp.einsum('bhnik,bhnjk->bhnij', k_beta, kc) * decay
    M = jnp.eye(C, dtype=f32) + jnp.where(strict, kkt, 0.0)
    u = lax.linalg.triangular_solve(M, v_beta, left_side=True, lower=True, unit_diagonal=True)
    w = lax.linalg.triangular_solve(M, k_beta * jnp.exp(G)[..., None], left_side=True,
                                    lower=True, unit_diagonal=True)
    qk = jnp.einsum('bhnik,bhnjk->bhnij', qc, kc) * decay
    q_dec = qc * jnp.exp(G)[..., None]
    k_dec = kc * jnp.exp(G[..., -1:] - G)[..., None]
    g_last = jnp.exp(G[..., -1])

    def step(state, inp):
        qk_i, u_i, w_i, q_i, k_i, gl = inp
        v_new = u_i - jnp.einsum('bhck,bhkv->bhcv', w_i, state)
        o = jnp.einsum('bhck,bhkv->bhcv', q_i, state) + jnp.einsum('bhcj,bhjv->bhcv', qk_i, v_new)
        state = state * gl[..., None, None] + jnp.einsum('bhck,bhcv->bhkv', k_i, v_new)
        return state, o

    xs = tuple(jnp.moveaxis(t, 2, 0) for t in (qk, u, w, q_dec, k_dec, g_last))
    s0 = jnp.zeros((b, h, dk, dv), f32)
    _, o = lax.scan(step, s0, xs)
    o = jnp.moveaxis(o, 0, 2).reshape(b, h, s, dv)
    return o.transpose(0, 2, 1, 3)


def sliding_window_attention(q, k, v, sinks):
    b, s, hq, d = q.shape
    hkv = k.shape[2]
    grp = hq // hkv
    W = SWA_WINDOW
    nb = s // W
    qb = q.reshape(b, nb, W, hkv, grp, d)
    kp = jnp.pad(k, ((0, 0), (W, 0), (0, 0), (0, 0))).reshape(b, nb + 1, W, hkv, d)
    vp = jnp.pad(v, ((0, 0), (W, 0), (0, 0), (0, 0))).reshape(b, nb + 1, W, hkv, d)
    kk = jnp.concatenate([kp[:, :-1], kp[:, 1:]], axis=2)
    vv = jnp.concatenate([vp[:, :-1], vp[:, 1:]], axis=2)
    scores = jnp.einsum('bnqhgd,bnkhd->bhgnqk', qb, kk).astype(jnp.float32) * (d ** -0.5)
    qrel = W + jnp.arange(W)[:, None]
    krel = jnp.arange(2 * W)[None, :]
    nidx = jnp.arange(nb)[:, None, None]
    mask = (krel <= qrel) & (krel > qrel - W) & ((nidx > 0) | (krel >= W))
    scores = jnp.where(mask, scores, -jnp.inf)
    sink = jnp.broadcast_to(sinks.astype(jnp.float32).reshape(hkv, grp)[None, :, :, None, None, None],
                            scores.shape[:-1] + (1,))
    p = jax.nn.softmax(jnp.concatenate([scores, sink], axis=-1), axis=-1)[..., :-1]
    out = jnp.einsum('bhgnqk,bnkhd->bnqhgd', p.astype(v.dtype), vv)
    return out.reshape(b, s, hq * d).astype(v.dtype)


def hybrid_layer(x, norm_mix, w_in, moba_q_norm, moba_k_norm, gdn_conv, gdn_a_log, gdn_dt_bias,
                 gdn_out_norm, sc_conv, swa_q_norm, swa_k_norm, swa_sinks, w_out, norm_ffn,
                 w_gate, w_up, w_down):
    b, s, _ = x.shape
    h = rmsnorm(x, norm_mix)
    proj = h @ w_in
    (mq, mk, mv, gqkv, ga, gb, gz, scb, scc, scx, sq, sk, sv) = jnp.split(proj, SPLIT_POINTS, axis=-1)

    mq = rmsnorm(mq.reshape(b, s, MOBA_HEADS, HEAD_DIM), moba_q_norm)
    mk = rmsnorm(mk.reshape(b, s, MOBA_HEADS, HEAD_DIM), moba_k_norm)
    mv = mv.reshape(b, s, MOBA_HEADS, HEAD_DIM)
    o_a = moba_attention(mq, mk, mv)

    gqkv = jax.nn.silu(causal_conv(gqkv, gdn_conv))
    gq, gk, gv = jnp.split(gqkv, 3, axis=-1)
    gq = l2norm(gq.reshape(b, s, GDN_HEADS, HEAD_DIM))
    gk = l2norm(gk.reshape(b, s, GDN_HEADS, HEAD_DIM))
    gv = gv.reshape(b, s, GDN_HEADS, HEAD_DIM)
    log_decay = -jnp.exp(gdn_a_log.astype(jnp.float32)) * jax.nn.softplus(
        ga.astype(jnp.float32) + gdn_dt_bias.astype(jnp.float32))
    beta = jax.nn.sigmoid(gb.astype(jnp.float32))
    o = gated_delta_rule(gq, gk, gv, log_decay, beta)
    zg = jax.nn.silu(gz.reshape(b, s, GDN_HEADS, HEAD_DIM).astype(jnp.float32))
    o_b = (rmsnorm(o, gdn_out_norm) * zg).reshape(b, s, GROUP_WIDTH).astype(x.dtype)

    o_c = scb * causal_conv(scc * scx, sc_conv)

    sq = rmsnorm(sq.reshape(b, s, SWA_Q_HEADS, SWA_HEAD_DIM), swa_q_norm)
    sk = rmsnorm(sk.reshape(b, s, SWA_KV_HEADS, SWA_HEAD_DIM), swa_k_norm)
    sv = sv.reshape(b, s, SWA_KV_HEADS, SWA_HEAD_DIM)
    o_d = sliding_window_attention(sq, sk, sv, swa_sinks)

    mix = jnp.concatenate([o_a, o_b, o_c.astype(x.dtype), o_d], axis=-1)
    x = x + mix @ w_out

    h = rmsnorm(x, norm_ffn)
    x = x + (jax.nn.silu(h @ w_gate) * (h @ w_up)) @ w_down
    return x


def setup_inputs(seed: int = 0) -> dict:
    key = jax.random.key(seed)
    ks = jax.random.split(key, 20)

    def nrm(k, shape, scale):
        return jax.random.normal(k, shape, jnp.float32) * scale

    dt = jnp.exp(jax.random.uniform(ks[7], (DEPTH, GDN_HEADS), jnp.float32,
                                    minval=math.log(1e-3), maxval=math.log(1e-1)))
    return {
        "x": nrm(ks[0], (BATCH, SEQ, D_MODEL), 1.0),
        "norm_mix": 1.0 + nrm(ks[1], (DEPTH, D_MODEL), 0.02),
        "w_in": nrm(ks[2], (DEPTH, D_MODEL, IN_WIDTH), D_MODEL ** -0.5),
        "moba_q_norm": 1.0 + nrm(ks[3], (DEPTH, HEAD_DIM), 0.02),
        "moba_k_norm": 1.0 + nrm(ks[4], (DEPTH, HEAD_DIM), 0.02),
        "gdn_conv": nrm(ks[5], (DEPTH, GDN_CONV, 3 * GROUP_WIDTH), GDN_CONV ** -0.5),
        "gdn_a_log": jnp.log(jax.random.uniform(ks[6], (DEPTH, GDN_HEADS), jnp.float32,
                                                minval=1.0, maxval=16.0)),
        "gdn_dt_bias": dt + jnp.log(-jnp.expm1(-dt)),
        "gdn_out_norm": 1.0 + nrm(ks[8], (DEPTH, HEAD_DIM), 0.02),
        "sc_conv": nrm(ks[9], (DEPTH, SC_CONV, GROUP_WIDTH), SC_CONV ** -0.5),
        "swa_q_norm": 1.0 + nrm(ks[10], (DEPTH, SWA_HEAD_DIM), 0.02),
        "swa_k_norm": 1.0 + nrm(ks[11], (DEPTH, SWA_HEAD_DIM), 0.02),
        "swa_sinks": nrm(ks[12], (DEPTH, SWA_Q_HEADS), 1.0),
        "w_out": nrm(ks[13], (DEPTH, MIX_WIDTH, D_MODEL), MIX_WIDTH ** -0.5),
        "norm_ffn": 1.0 + nrm(ks[14], (DEPTH, D_MODEL), 0.02),
        "w_gate": nrm(ks[15], (DEPTH, D_MODEL, D_FF), D_MODEL ** -0.5),
        "w_up": nrm(ks[16], (DEPTH, D_MODEL, D_FF), D_MODEL ** -0.5),
        "w_down": nrm(ks[17], (DEPTH, D_FF, D_MODEL), D_FF ** -0.5),
    }


def reference(x, norm_mix, w_in, moba_q_norm, moba_k_norm, gdn_conv, gdn_a_log, gdn_dt_bias,
              gdn_out_norm, sc_conv, swa_q_norm, swa_k_norm, swa_sinks, w_out, norm_ffn,
              w_gate, w_up, w_down):
    for l in range(DEPTH):
        x = hybrid_layer(x, norm_mix[l], w_in[l], moba_q_norm[l], moba_k_norm[l], gdn_conv[l],
                         gdn_a_log[l], gdn_dt_bias[l], gdn_out_norm[l], sc_conv[l], swa_q_norm[l],
                         swa_k_norm[l], swa_sinks[l], w_out[l], norm_ffn[l], w_gate[l], w_up[l],
                         w_down[l])
    return x
```

```cpp
#include <hip/hip_runtime.h>
#include <cstdio>
#include <cstdint>
#include <cmath>
namespace pg8 {
#define PG8_LAS __attribute__((address_space(3)))
typedef unsigned short bf16_t;
typedef short bf16x8 __attribute__((ext_vector_type(8)));
typedef float f32x4 __attribute__((ext_vector_type(4)));
typedef unsigned u32x4 __attribute__((ext_vector_type(4)));
constexpr int BM = 256, BK = 64, HALF = 128, HTB = HALF * BK * 2  , STAGE_BYTES = 8 * HTB, NXCD = 8, WGM = 8;

__host__ __device__ __forceinline__ int lds_byte(int r, int c) { const int st = (r >> 4) * 2 + (c >> 5), rr = r & 15, cc = c & 31, ob = rr * 64 + cc * 2; return st * 1024 + (ob ^ (((ob >> 9) & 1) << 5)); }
__host__ __device__ __forceinline__ void stage_rc(int b, int& R, int& C) { const int st = b / 1024, sb = b % 1024, swz = sb ^ (((sb >> 9) & 1) << 5); R = (st >> 1) * 16 + swz / 64; C = (st & 1) * 32 + (swz % 64) / 2; }
__host__ __device__ __forceinline__ int perm32(int rho) { const int n = rho >> 4, i = rho & 15; return 8 * (i >> 2) + 4 * n + (i & 3); }

struct Unit { int pm, pn; };
struct Gemm { const bf16_t* A; const bf16_t* Bt; int M, N, K; };

struct StaticOrder {
    int nM, nN, nwg, G, c;
    __host__ __device__ void init(int M, int N, int G_, int c_) { nM = M / BM; nN = N / BM; nwg = nM * nN; G = G_; c = c_; }
    __host__ __device__ bool next(int i, Unit& u) const {
        const long L = (long)i * G + c; if (L >= nwg) return false;
        int wgid = (int)L; { const int q = nwg / NXCD, r = nwg % NXCD, xcd = wgid % NXCD, off = wgid / NXCD; wgid = (xcd < r ? xcd * (q + 1) : r * (q + 1) + (xcd - r) * q) + off; }
        const int nig = WGM * nN, gid = wgid / nig, fm = gid * WGM, gsz = (nM - fm) < WGM ? (nM - fm) : WGM;
        u.pm = fm + ((wgid % nig) % gsz); u.pn = (wgid % nig) / gsz; return true;
    }
    __device__ __forceinline__ void a_ready(const Unit&) const {}
    __device__ __forceinline__ void done(const Unit&) const {}
};

__device__ __forceinline__ unsigned cvt_pk_bf16(float lo, float hi) { unsigned r; asm volatile("v_cvt_pk_bf16_f32 %0, %1, %2" : "=v"(r) : "v"(lo), "v"(hi)); return r; }

struct EpiBf16Plain {
    static constexpr bool PERM = true, AFTER_DRAIN = false;
    bf16_t* O; int ldc;
    __device__ __forceinline__ void operator()(const f32x4 (&acc)[2][2][4][2], const Unit& u, int wr, int wc, int fr, int fq) const {
        const int row0 = u.pm * BM + wr * 64 + fr; const int col0 = u.pn * BM + wc * 32 + 8 * fq;
#pragma unroll
        for (int ai = 0; ai < 2; ++ai)
#pragma unroll
            for (int m = 0; m < 4; ++m) { bf16_t* rowp = O + (size_t)(row0 + ai * HALF + m * 16) * ldc + col0;
#pragma unroll
                for (int bj = 0; bj < 2; ++bj) { const f32x4 v0 = acc[ai][bj][m][0], v1 = acc[ai][bj][m][1];
                    u32x4 w; w.x = cvt_pk_bf16(v0[0], v0[1]); w.y = cvt_pk_bf16(v0[2], v0[3]); w.z = cvt_pk_bf16(v1[0], v1[1]); w.w = cvt_pk_bf16(v1[2], v1[3]);
                    *(u32x4*)(rowp + bj * HALF) = w; } }
    }
};
struct EpiResF32 {
    static constexpr bool PERM = false, AFTER_DRAIN = false;
    const float* base; float* C; int ldc;
    __device__ __forceinline__ void operator()(const f32x4 (&acc)[2][2][4][2], const Unit& u, int wr, int wc, int fr, int fq) const {
        const int row0 = u.pm * BM + wr * 64 + fr, col0 = u.pn * BM + wc * 32 + 4 * fq;
#pragma unroll
        for (int ai = 0; ai < 2; ++ai)
#pragma unroll
            for (int m = 0; m < 4; ++m) { const size_t off = (size_t)(row0 + ai * HALF + m * 16) * ldc + col0;
                f32x4 bs[2][2];
#pragma unroll
                for (int bj = 0; bj < 2; ++bj)
#pragma unroll
                    for (int n = 0; n < 2; ++n) bs[bj][n] = *(const f32x4*)(base + off + bj * HALF + n * 16);
#pragma unroll
                for (int bj = 0; bj < 2; ++bj)
#pragma unroll
                    for (int n = 0; n < 2; ++n) *(f32x4*)(C + off + bj * HALF + n * 16) = acc[ai][bj][m][n] + bs[bj][n];
                asm volatile("" ::: "memory"); }
    }
};
struct EpiSwiGLU {
    static constexpr bool PERM = true, AFTER_DRAIN = false;
    bf16_t* O; int ldc;
    static __device__ __forceinline__ float sg(float g, float uu) { return g * uu * __builtin_amdgcn_rcpf(1.0f + __expf(-g)); }
    __device__ __forceinline__ void operator()(const f32x4 (&acc)[2][2][4][2], const Unit& u, int wr, int wc, int fr, int fq) const {
        const int row0 = u.pm * BM + wr * 64 + fr; const int col0 = u.pn * HALF + wc * 32 + 8 * fq;
#pragma unroll
        for (int ai = 0; ai < 2; ++ai)
#pragma unroll
            for (int m = 0; m < 4; ++m) { bf16_t* rowp = O + (size_t)(row0 + ai * HALF + m * 16) * ldc + col0;
                const f32x4 g0 = acc[ai][0][m][0], g1 = acc[ai][0][m][1], u0 = acc[ai][1][m][0], u1 = acc[ai][1][m][1];
                u32x4 w; w.x = cvt_pk_bf16(sg(g0[0], u0[0]), sg(g0[1], u0[1])); w.y = cvt_pk_bf16(sg(g0[2], u0[2]), sg(g0[3], u0[3]));
                w.z = cvt_pk_bf16(sg(g1[0], u1[0]), sg(g1[1], u1[1])); w.w = cvt_pk_bf16(sg(g1[2], u1[2]), sg(g1[3], u1[3]));
                *(u32x4*)rowp = w; }
    }
};

template <class Epi, class Sched, bool ALIGN_EPI = false, bool SP2 = false>
__device__ __forceinline__ void gemm_phase(PG8_LAS unsigned char* lds, const Gemm g, const Sched& S, const Epi& E) {
    int tid_ = threadIdx.x; asm volatile("" : "+v"(tid_));
    const int tid = tid_, wid = __builtin_amdgcn_readfirstlane(tid >> 6), lane = tid & 63, wr = wid >> 2, wc = wid & 3, fr = lane & 15, fq = lane >> 4;
    const int K = g.K, nt = K / BK;
    unsigned voffA[2], voffB[2];
#pragma unroll
    for (int i = 0; i < 2; ++i) { int R, C; stage_rc(tid * 16 + i * 8192, R, C); const int Rb = Epi::PERM ? ((R & ~31) + perm32(R & 31)) : R;
        voffA[i] = (unsigned)(R * K + C) * 2u; voffB[i] = (unsigned)(Rb * K + C) * 2u; }
    const size_t kstep = (size_t)(BK * 2);
    const size_t hstep = (size_t)HALF * K * 2;
    const size_t tstep = 2 * hstep;
    const unsigned ldsw = (unsigned)wid * 1024u;
    const int aoff = lds_byte(wr * 64 + fr, fq * 8), boff = lds_byte(wc * 32 + fr, fq * 8);
#define PG8_SA(b, h) (((b) * 2 + (h)) * HTB)
#define PG8_SB(b, h) ((4 + (b) * 2 + (h)) * HTB)
#define PG8_STAGE(bufoff, gbase, voff) do { _Pragma("unroll") for (int _i = 0; _i < 2; ++_i) \
        __builtin_amdgcn_global_load_lds((const unsigned*)((const char*)(gbase) + (voff)[_i]), (PG8_LAS unsigned*)(lds + (bufoff) + ldsw + _i * 8192), 16, 0, 0); } while (0)
#define PG8_LDA(dst, b, h) do { _Pragma("unroll") for (int m = 0; m < 4; ++m) _Pragma("unroll") for (int k = 0; k < 2; ++k) dst[m][k] = *(const PG8_LAS bf16x8*)(lds + PG8_SA(b, h) + aoff + m * 2048 + k * 1024); } while (0)
#define PG8_LDB(dst, b, h) do { _Pragma("unroll") for (int n = 0; n < 2; ++n) _Pragma("unroll") for (int k = 0; k < 2; ++k) dst[n][k] = *(const PG8_LAS bf16x8*)(lds + PG8_SB(b, h) + boff + n * 2048 + k * 1024); } while (0)
#define PG8_MMA(ai, bj, At, Bt) do { __builtin_amdgcn_s_setprio(1); _Pragma("unroll") for (int m = 0; m < 4; ++m) _Pragma("unroll") for (int n = 0; n < 2; ++n) _Pragma("unroll") for (int k = 0; k < 2; ++k) \
        acc[ai][bj][m][n] = __builtin_amdgcn_mfma_f32_16x16x32_bf16(Bt[n][k], At[m][k], acc[ai][bj][m][n], 0, 0, 0); __builtin_amdgcn_s_setprio(0); } while (0)
#define PG8_WAIT_V(n) asm volatile("s_waitcnt vmcnt(" #n ")" ::: "memory")
#define PG8_WAIT_L(n) asm volatile("s_waitcnt lgkmcnt(" #n ")" ::: "memory")
#define PG8_BAR __builtin_amdgcn_s_barrier()
#define PG8_SCHED __builtin_amdgcn_sched_barrier(0)
    Unit cur, nxt; int ui = 0;
    if (!S.next(0, cur)) return;
    f32x4 acc[2][2][4][2];
#pragma unroll
    for (int a = 0; a < 2; ++a)
#pragma unroll
        for (int b = 0; b < 2; ++b)
#pragma unroll
            for (int m = 0; m < 4; ++m)
#pragma unroll
                for (int n = 0; n < 2; ++n) acc[a][b][m][n] = (f32x4){0.f, 0.f, 0.f, 0.f};
    bf16x8 At[4][2], B0[2][2], B1[2][2];
    const char* cA = (const char*)g.A + (size_t)cur.pm * tstep; const char* cB = (const char*)g.Bt + (size_t)cur.pn * tstep;
    S.a_ready(cur);
    if constexpr (SP2) {
        PG8_STAGE(PG8_SB(0, 0), cB, voffB); PG8_STAGE(PG8_SB(0, 1), cB + hstep, voffB); PG8_STAGE(PG8_SA(0, 0), cA, voffA); PG8_STAGE(PG8_SA(0, 1), cA + hstep, voffA);
        if (wr == 1) PG8_BAR;
        PG8_WAIT_V(2); PG8_BAR;
        PG8_STAGE(PG8_SB(1, 0), cB + kstep, voffB); PG8_STAGE(PG8_SA(1, 0), cA + kstep, voffA); PG8_STAGE(PG8_SB(1, 1), cB + hstep + kstep, voffB);
        PG8_WAIT_V(6); PG8_BAR;
    } else {
        PG8_STAGE(PG8_SB(0, 0), cB, voffB); PG8_STAGE(PG8_SA(0, 0), cA, voffA); PG8_STAGE(PG8_SB(0, 1), cB + hstep, voffB); PG8_STAGE(PG8_SA(0, 1), cA + hstep, voffA);
        if (wr == 1) PG8_BAR;
        PG8_WAIT_V(4); PG8_BAR;
        PG8_STAGE(PG8_SB(1, 0), cB + kstep, voffB); PG8_STAGE(PG8_SA(1, 0), cA + kstep, voffA); PG8_STAGE(PG8_SB(1, 1), cB + hstep + kstep, voffB);
        PG8_WAIT_V(6); PG8_BAR;
    }
    for (;;) {
        const bool has_next = S.next(ui + 1, nxt);
        const char* nA = has_next ? (const char*)g.A + (size_t)nxt.pm * tstep : cA; const char* nB = has_next ? (const char*)g.Bt + (size_t)nxt.pn * tstep : cB;
        for (int t = 0; t < nt; t += 2) {
            const bool last = (t == nt - 2);
            const char* a1 = cA + (size_t)(t + 1) * kstep;
            const char* a2 = last ? nA : cA + (size_t)(t + 2) * kstep; const char* b2 = last ? nB : cB + (size_t)(t + 2) * kstep;
            const char* a3 = a2 + kstep; const char* b3 = b2 + kstep;
            if (last && has_next) S.a_ready(nxt);
            if constexpr (SP2) {
            PG8_LDB(B0, 0, 0); PG8_LDB(B1, 0, 1); PG8_SCHED; PG8_LDA(At, 0, 0); PG8_STAGE(PG8_SA(1, 1), a1 + hstep, voffA);
            PG8_WAIT_V(8); PG8_WAIT_L(0); PG8_BAR; PG8_MMA(0, 0, At, B0); PG8_MMA(0, 1, At, B1); PG8_BAR; PG8_SCHED;
            PG8_LDA(At, 0, 1); PG8_STAGE(PG8_SB(0, 0), b2, voffB); PG8_STAGE(PG8_SB(0, 1), b2 + hstep, voffB); PG8_STAGE(PG8_SA(0, 0), a2, voffA);
            PG8_WAIT_V(8); PG8_WAIT_L(0); PG8_BAR; PG8_MMA(1, 0, At, B0); PG8_MMA(1, 1, At, B1); PG8_BAR; PG8_SCHED;
            PG8_LDB(B0, 1, 0); PG8_LDB(B1, 1, 1); PG8_SCHED; PG8_LDA(At, 1, 0); PG8_STAGE(PG8_SA(0, 1), a2 + hstep, voffA);
            PG8_WAIT_V(8); PG8_WAIT_L(0); PG8_BAR; PG8_MMA(0, 0, At, B0); PG8_MMA(0, 1, At, B1); PG8_BAR; PG8_SCHED;
            PG8_LDA(At, 1, 1); PG8_STAGE(PG8_SB(1, 0), b3, voffB); PG8_STAGE(PG8_SB(1, 1), b3 + hstep, voffB); PG8_STAGE(PG8_SA(1, 0), a3, voffA);
            PG8_WAIT_V(8); PG8_WAIT_L(0); PG8_BAR; PG8_MMA(1, 0, At, B0); PG8_MMA(1, 1, At, B1); PG8_BAR; PG8_SCHED;
            } else {
            PG8_LDB(B0, 0, 0); PG8_SCHED; PG8_LDA(At, 0, 0); PG8_STAGE(PG8_SA(1, 1), a1 + hstep, voffA);
            PG8_WAIT_L(8); PG8_BAR; PG8_WAIT_L(0); PG8_MMA(0, 0, At, B0); PG8_BAR; PG8_SCHED;
            PG8_LDB(B1, 0, 1); PG8_STAGE(PG8_SB(0, 0), b2, voffB);
            PG8_BAR; PG8_WAIT_L(0); PG8_MMA(0, 1, At, B1); PG8_BAR;
            PG8_LDA(At, 0, 1); PG8_STAGE(PG8_SA(0, 0), a2, voffA);
            PG8_BAR; PG8_WAIT_L(0); PG8_MMA(1, 0, At, B0); PG8_BAR; PG8_SCHED;
            PG8_STAGE(PG8_SB(0, 1), b2 + hstep, voffB);
            PG8_WAIT_V(6); PG8_BAR; PG8_MMA(1, 1, At, B1); PG8_BAR;
            PG8_LDB(B0, 1, 0); PG8_SCHED; PG8_LDA(At, 1, 0); PG8_STAGE(PG8_SA(0, 1), a2 + hstep, voffA);
            PG8_WAIT_L(8); PG8_BAR; PG8_WAIT_L(0); PG8_MMA(0, 0, At, B0); PG8_BAR; PG8_SCHED;
            PG8_LDB(B1, 1, 1); PG8_STAGE(PG8_SB(1, 0), b3, voffB);
            PG8_BAR; PG8_WAIT_L(0); PG8_MMA(0, 1, At, B1); PG8_BAR;
            PG8_LDA(At, 1, 1); PG8_STAGE(PG8_SA(1, 0), a3, voffA);
            PG8_BAR; PG8_WAIT_L(0); PG8_MMA(1, 0, At, B0); PG8_BAR; PG8_SCHED;
            PG8_STAGE(PG8_SB(1, 1), b3 + hstep, voffB);
            PG8_WAIT_V(6); PG8_BAR; PG8_MMA(1, 1, At, B1); PG8_BAR;
            }
        }
        if constexpr (ALIGN_EPI) { if (wr == 0) PG8_BAR; }
        if constexpr (!Epi::AFTER_DRAIN) { E(acc, cur, wr, wc, fr, fq); S.done(cur); }
        if (!has_next) break;
#pragma unroll
        for (int a = 0; a < 2; ++a)
#pragma unroll
            for (int b = 0; b < 2; ++b)
#pragma unroll
                for (int m = 0; m < 4; ++m)
#pragma unroll
                    for (int n = 0; n < 2; ++n) acc[a][b][m][n] = (f32x4){0.f, 0.f, 0.f, 0.f};
        cur = nxt; cA = nA; cB = nB; ++ui;
        if constexpr (ALIGN_EPI) { if (wr == 1) PG8_BAR; }
    }
    PG8_WAIT_V(0);
    if constexpr (!ALIGN_EPI) { if (wr == 0) PG8_BAR; }
    PG8_BAR;
    if constexpr (Epi::AFTER_DRAIN) { E.fused(acc, cur, wr, wc, fr, fq, lds, wid, lane); S.done(cur); }
#undef PG8_SA
#undef PG8_SB
#undef PG8_STAGE
#undef PG8_LDA
#undef PG8_LDB
#undef PG8_MMA
#undef PG8_WAIT_V
#undef PG8_WAIT_L
#undef PG8_BAR
#undef PG8_SCHED
}
}
#define GAS __attribute__((address_space(1)))
#define LAS __attribute__((address_space(3)))
typedef unsigned short bf16;
typedef unsigned v4u __attribute__((ext_vector_type(4)));
typedef float f32x4 __attribute__((ext_vector_type(4)));
typedef short bf16x8 __attribute__((ext_vector_type(8)));
typedef GAS unsigned gu32;
typedef GAS unsigned long long gu64;
#define RLX_AGENT __ATOMIC_RELAXED, __HIP_MEMORY_SCOPE_AGENT
#define LDS_WAIT() asm volatile("s_waitcnt lgkmcnt(0)" ::: "memory")
#define VM_WAIT() asm volatile("s_waitcnt vmcnt(0)" ::: "memory")
__device__ __forceinline__ unsigned long long rt() { return __builtin_amdgcn_s_memrealtime(); }
__device__ __forceinline__ unsigned f2bf(float f) { unsigned u = __builtin_bit_cast(unsigned, f); return (u + 0x7fffu + ((u >> 16) & 1u)) >> 16; }
__device__ __forceinline__ unsigned pk2(float lo, float hi) { return f2bf(lo) | (f2bf(hi) << 16); }

#define XB_TMO      128
#define XB_XCNT(j)  (256  + 64 * (j))
#define XB_XSUB(j)  (1280 + 64 * (j))
#define XB_XGEN(j)  (2304 + 64 * (j))
#define XB_TOP      3328
#define XB_TOPGEN   3392
#define XCD_BAR_WORDS 3456
#define XB_SPIN_CAP (1u << 21)

__device__ __forceinline__ unsigned xb_ld(unsigned* p)              { return __hip_atomic_load(p, __ATOMIC_RELAXED, __HIP_MEMORY_SCOPE_AGENT); }
__device__ __forceinline__ unsigned xb_add(unsigned* p, unsigned v) { return __hip_atomic_fetch_add(p, v, __ATOMIC_RELAXED, __HIP_MEMORY_SCOPE_AGENT); }
__device__ __forceinline__ unsigned xb_xcc_id() { return (unsigned)__builtin_amdgcn_s_getreg((3 << 11) | 20) & 0xFu; }
#define XB_SPIN(cond, bar) do { unsigned _sp = 0; while (cond) { __builtin_amdgcn_s_sleep(1); \
    if ((++_sp & 255u) == 0u) { if (xb_ld(&(bar)[XB_TMO])) break; if (_sp > XB_SPIN_CAP) { atomicAdd(&(bar)[XB_TMO], 1u); break; } } } } while (0)

struct XcdBarrier {
    unsigned* bar; unsigned x;
    volatile LAS unsigned* st;
};

__device__ __forceinline__ XcdBarrier xcd_barrier_post(unsigned* bar, volatile LAS unsigned* st) {
    XcdBarrier b; b.bar = bar; b.x = xb_xcc_id(); b.st = st;
    if (threadIdx.x == 0) (void)xb_add(&bar[XB_XCNT(b.x)], 1u);
    return b;
}
__device__ __forceinline__ void xcd_barrier_complete(unsigned* bar, unsigned x, unsigned& nloc, unsigned& nx) {
    const unsigned G = gridDim.x * gridDim.y * gridDim.z;
    unsigned sum, cnt, mine, sp = 0u;
    for (;;) {
        sum = 0u; cnt = 0u; mine = 0u;
#pragma unroll
        for (unsigned j = 0; j < 16; ++j) { const unsigned c = xb_ld(&bar[XB_XCNT(j)]); sum += c; cnt += (c > 0u) ? 1u : 0u; mine = (j == x) ? c : mine; }
        if (sum == G) break;
        __builtin_amdgcn_s_sleep(1);
        if ((++sp & 255u) == 0u) { if (xb_ld(&bar[XB_TMO])) break; if (sp > XB_SPIN_CAP) { atomicAdd(&bar[XB_TMO], 1u); break; } }
    }
    nloc = mine > 0u ? mine : 1u; nx = cnt > 0u ? cnt : 1u;
}

__device__ __forceinline__ void xcd_barrier(const XcdBarrier& b) {
    asm volatile("s_waitcnt vmcnt(0)" ::: "memory");
    __syncthreads();
    if (threadIdx.x == 0) {
        unsigned* bar = b.bar;
        __builtin_amdgcn_s_waitcnt(0);
        unsigned nloc = b.st[0], nx = b.st[1];
        if (nloc == 0u) { xcd_barrier_complete(bar, b.x, nloc, nx); b.st[0] = nloc; b.st[1] = nx; }
        const unsigned old = xb_add(&bar[XB_XSUB(b.x)], 1u);
        const unsigned gen = old / nloc;
        if (old + 1u == (gen + 1u) * nloc) {
            __builtin_amdgcn_fence(__ATOMIC_RELEASE, "agent");
            asm volatile("s_waitcnt vmcnt(0)" ::: "memory");
            const unsigned og = xb_add(&bar[XB_TOP], 1u);
            const unsigned tg = og / nx;
            if (og + 1u == (tg + 1u) * nx) xb_add(&bar[XB_TOPGEN], 1u);
            else XB_SPIN(xb_ld(&bar[XB_TOPGEN]) == tg, bar);
            __builtin_amdgcn_fence(__ATOMIC_ACQUIRE, "agent");
            xb_add(&bar[XB_XGEN(b.x)], 1u);
            asm volatile("s_waitcnt vmcnt(0)" ::: "memory");
        } else {
            XB_SPIN(xb_ld(&bar[XB_XGEN(b.x)]) == gen, bar);
            __builtin_amdgcn_fence(__ATOMIC_ACQUIRE, "agent");
            asm volatile("s_waitcnt vmcnt(0)" ::: "memory");
        }
    }
    __syncthreads();
}
constexpr int NWAVES = 8;
constexpr int BATCH = 2, SEQ = 8192, M = BATCH * SEQ, D = 4096, DEPTH = 2;
constexpr int GWID = 1024, HD = 128, NHEAD = 8;
constexpr int IN_REAL = 11536, NIN = 11776, DFF = 11008, NGU = 2 * DFF;
constexpr float EPS = 1e-6f;
constexpr int PC_MQ = 0, PC_MK = 1024, PC_MV = 2048, PC_GQ = 3072, PC_GK = 4096, PC_GV = 5120, PC_GZ = 6144, PC_SCB = 7168, PC_SCC = 8192, PC_SCX = 9216,
              PC_SQ = 10240, PC_SK = 11264, PC_SV = 11392, PC_GA = 11520, PC_GB = 11528;
constexpr int MC_A = 0, MC_B = 1024, MC_C = 2048, MC_D = 3072;
constexpr int MOBA_BLK = 256, MOBA_NB = SEQ / MOBA_BLK, SWA_W = 128;

constexpr size_t MiB = 1u << 20;
constexpr size_t WS_CTL = 0, CTL_ZERO_BYTES = 1 * MiB;
constexpr size_t WS_WIN = 2 * MiB, WS_WOUT = 94 * MiB, WS_WGU = 126 * MiB, WS_WDN = 298 * MiB;
constexpr size_t WS_H = 384 * MiB, WS_MIX = 512 * MiB, WS_PROJ = 640 * MiB, WS_ACT = WS_PROJ;
constexpr size_t WS_QN = 1008 * MiB, WS_KN = 1040 * MiB, WS_SQN = 1072 * MiB, WS_SKN = 1104 * MiB, WS_KMEAN = 1108 * MiB;
constexpr size_t WS_GQ = 1110 * MiB, WS_GK = 1142 * MiB, WS_GV = 1174 * MiB, WS_GG = 1206 * MiB, WS_GBETA = WS_GG + 512 * 1024, WS_GO = 1208 * MiB, WS_END = 1272 * MiB;
static_assert(WS_WIN + (size_t)NIN * D * 2 <= WS_WOUT && WS_WOUT + (size_t)D * D * 2 <= WS_WGU && WS_WGU + (size_t)NGU * D * 2 <= WS_WDN && WS_WDN + (size_t)D * DFF * 2 <= WS_H, "weights map");
static_assert(WS_PROJ + (size_t)M * NIN * 2 <= WS_QN && WS_GO + (size_t)M * GWID * 4 <= WS_END, "ws map");
constexpr int CW_BAR = 4096;

constexpr int RING_OFF = 0, RING_BYTES = 131072;
constexpr int LDSCTL_OFF = RING_BYTES, MISC_OFF = LDSCTL_OFF + 320;
constexpr int LDS_BYTES = 147456;

struct Frame {
    LAS unsigned char* lds;
    volatile LAS unsigned* MISC;
    gu32* ctl;
    int tid, lane, wave;
    int vcu, G;
};

__device__ __forceinline__ float wave_sum(float v) {
#pragma unroll
    for (int o = 1; o < 64; o <<= 1) v += __shfl_xor(v, o);
    return v;
}
__device__ __forceinline__ float wave_max(float v) {
#pragma unroll
    for (int o = 1; o < 64; o <<= 1) v = fmaxf(v, __shfl_xor(v, o));
    return v;
}
__device__ __forceinline__ float bf_lo(unsigned w) { return __builtin_bit_cast(float, w << 16); }
__device__ __forceinline__ float bf_hi(unsigned w) { return __builtin_bit_cast(float, w & 0xffff0000u); }
__device__ __forceinline__ float bf1(bf16 h) { return __builtin_bit_cast(float, ((unsigned)h) << 16); }
__device__ __forceinline__ float silu_f(float x) { return x / (1.0f + __expf(-x)); }

template <class SrcCol>
__device__ __forceinline__ void transpose_item(const float* W, int K, int N, bf16* WT, LAS float* scr, int kb, int nb, int lane, SrcCol srcCol) {
    const int k0 = 64 * kb, n0 = 32 * nb;
    const int sc = srcCol(n0 + (lane & 31));
#pragma unroll 8
    for (int i = 0; i < 32; ++i) { const int kk = 2 * i + (lane >> 5); scr[kk * 33 + (lane & 31)] = (sc >= 0) ? W[(size_t)(k0 + kk) * N + sc] : 0.0f; }
    LDS_WAIT(); asm volatile("" ::: "memory");
    const int c = lane & 7;
#pragma unroll
    for (int j = 0; j < 4; ++j) { const int n = (lane >> 3) + 8 * j; const LAS float* s = scr + (8 * c) * 33 + n;
        v4u o; o.x = pk2(s[0 * 33], s[1 * 33]); o.y = pk2(s[2 * 33], s[3 * 33]); o.z = pk2(s[4 * 33], s[5 * 33]); o.w = pk2(s[6 * 33], s[7 * 33]);
        *(GAS v4u*)(WT + (size_t)(n0 + n) * K + k0 + 8 * c) = o; }
    LDS_WAIT(); asm volatile("" ::: "memory");
}

struct LayerW {
    const float *norm_mix, *w_in, *moba_qn, *moba_kn, *gdn_conv, *gdn_alog, *gdn_dtb, *gdn_onorm, *sc_conv, *swa_qn, *swa_kn, *swa_sinks, *w_out, *norm_ffn, *w_gate, *w_up, *w_down;
};

__device__ __forceinline__ void phase_convert_weights(Frame& F, const LayerW& L, unsigned char* ws) {
    LAS float* scr = (LAS float*)(F.lds + RING_OFF + F.wave * 16384);
    const int gw = F.vcu * NWAVES + F.wave, NGW = F.G * NWAVES;
    constexpr int I_IN = (D / 64) * (NIN / 32), I_OUT = (D / 64) * (D / 32), I_GU = (D / 64) * (NGU / 32), I_DN = (DFF / 64) * (D / 32);
    constexpr int NITEMS = I_IN + I_OUT + I_GU + I_DN;
    bf16* WIN = (bf16*)(ws + WS_WIN); bf16* WOUT = (bf16*)(ws + WS_WOUT); bf16* WGU = (bf16*)(ws + WS_WGU); bf16* WDN = (bf16*)(ws + WS_WDN);
    for (int it = gw; it < NITEMS; it += NGW) {
        int r = it;
        if (r < I_IN) { const int nblk = NIN / 32, kb = r / nblk, nb = r % nblk;
            transpose_item(L.w_in, D, IN_REAL, WIN, scr, kb, nb, F.lane, [](int d) { return d < 6144 ? d : (d < 11520 ? d + 16 : (d < 11536 ? d - 11520 + 6144 : -1)); }); continue; }
        r -= I_IN;
        if (r < I_OUT) { const int nblk = D / 32, kb = r / nblk, nb = r % nblk;
            transpose_item(L.w_out, D, D, WOUT, scr, kb, nb, F.lane, [](int d) { return d; }); continue; }
        r -= I_OUT;
        if (r < I_GU) { const int nblk = NGU / 32, kb = r / nblk, nb = r % nblk; const int row0 = nb * 32; const bool up = (row0 & 255) >= 128;
            transpose_item(up ? L.w_up : L.w_gate, D, DFF, WGU, scr, kb, nb, F.lane, [](int d) { return (d >> 8) * 128 + (d & 127); }); continue; }
        r -= I_GU;
        { const int nblk = D / 32, kb = r / nblk, nb = r % nblk;
            transpose_item(L.w_down, DFF, D, WDN, scr, kb, nb, F.lane, [](int d) { return d; }); }
    }
}

__device__ __forceinline__ void phase_rmsnorm(Frame& F, const float* X, const float* gain, bf16* O) {
    const int gw = F.vcu * NWAVES + F.wave, NGW = F.G * NWAVES;
    for (int m = gw; m < M; m += NGW) {
        const GAS f32x4* xr = (const GAS f32x4*)(X + (size_t)m * D) + F.lane;
        f32x4 v[16]; float s = 0.f;
#pragma unroll
        for (int j = 0; j < 16; ++j) { v[j] = xr[64 * j]; s += (v[j].x * v[j].x + v[j].y * v[j].y) + (v[j].z * v[j].z + v[j].w * v[j].w); }
        const float rstd = 1.0f / sqrtf(wave_sum(s) * (1.0f / D) + EPS);
        GAS unsigned long long* o8 = (GAS unsigned long long*)(O + (size_t)m * D) + F.lane;
        const GAS f32x4* gr = (const GAS f32x4*)gain + F.lane;
#pragma unroll
        for (int j = 0; j < 16; ++j) { const f32x4 g = gr[64 * j];
            o8[64 * j] = (unsigned long long)pk2(v[j].x * rstd * g.x, v[j].y * rstd * g.y) | ((unsigned long long)pk2(v[j].z * rstd * g.z, v[j].w * rstd * g.w) << 32); }
    }
}

__device__ __forceinline__ void phase_prep_moba(Frame& F, const LayerW& L, unsigned char* ws) {
    const bf16* PROJ = (const bf16*)(ws + WS_PROJ); bf16* QN = (bf16*)(ws + WS_QN); bf16* KN = (bf16*)(ws + WS_KN); float* KMEAN = (float*)(ws + WS_KMEAN);
    LAS float* part = (LAS float*)(F.lds + RING_OFF);
    const float gq0 = L.moba_qn[2 * F.lane], gq1 = L.moba_qn[2 * F.lane + 1], gk0 = L.moba_kn[2 * F.lane], gk1 = L.moba_kn[2 * F.lane + 1];
    for (int u = blockIdx.x; u < BATCH * MOBA_NB * NHEAD; u += F.G) {
        const int h = u % NHEAD, n = (u / NHEAD) % MOBA_NB, b = u / (NHEAD * MOBA_NB);
        float a0 = 0.f, a1 = 0.f;
        for (int i = 0; i < 32; ++i) {
            const size_t m = (size_t)b * SEQ + n * MOBA_BLK + F.wave * 32 + i;
            const unsigned qw = *(const GAS unsigned*)(PROJ + m * NIN + PC_MQ + h * HD + 2 * F.lane);
            const unsigned kw = *(const GAS unsigned*)(PROJ + m * NIN + PC_MK + h * HD + 2 * F.lane);
            float q0 = bf_lo(qw), q1 = bf_hi(qw), k0 = bf_lo(kw), k1 = bf_hi(kw);
            const float rq = 1.0f / sqrtf(wave_sum(q0 * q0 + q1 * q1) * (1.0f / HD) + EPS);
            const float rk = 1.0f / sqrtf(wave_sum(k0 * k0 + k1 * k1) * (1.0f / HD) + EPS);
            q0 *= rq * gq0; q1 *= rq * gq1; k0 *= rk * gk0; k1 *= rk * gk1;
            *(GAS unsigned*)(QN + m * GWID + h * HD + 2 * F.lane) = pk2(q0, q1);
            *(GAS unsigned*)(KN + m * GWID + h * HD + 2 * F.lane) = pk2(k0, k1);
            a0 += k0; a1 += k1;
        }
        part[F.wave * 128 + 2 * F.lane] = a0; part[F.wave * 128 + 2 * F.lane + 1] = a1;
        __syncthreads();
        if (F.wave == 0) { float s0 = 0.f, s1 = 0.f;
#pragma unroll
            for (int w = 0; w < 8; ++w) { s0 += part[w * 128 + 2 * F.lane]; s1 += part[w * 128 + 2 * F.lane + 1]; }
            float* km = KMEAN + ((size_t)(b * NHEAD + h) * MOBA_NB + n) * HD;
            km[2 * F.lane] = s0 * (1.0f / MOBA_BLK); km[2 * F.lane + 1] = s1 * (1.0f / MOBA_BLK); }
        __syncthreads();
    }
}
__device__ __forceinline__ void phase_prep_tokens(Frame& F, const LayerW& L, unsigned char* ws) {
    const bf16* PROJ = (const bf16*)(ws + WS_PROJ); bf16* SQN = (bf16*)(ws + WS_SQN); bf16* SKN = (bf16*)(ws + WS_SKN);
    bf16* GQ = (bf16*)(ws + WS_GQ); bf16* GK = (bf16*)(ws + WS_GK); bf16* GV = (bf16*)(ws + WS_GV); float* GG = (float*)(ws + WS_GG); float* GBETA = (float*)(ws + WS_GBETA);
    bf16* MIX = (bf16*)(ws + WS_MIX);
    const int gw = F.vcu * NWAVES + F.wave, NGW = F.G * NWAVES, lane = F.lane;
    for (int m = gw; m < M; m += NGW) {
        const int s = m % SEQ;
        const bf16* prow = PROJ + (size_t)m * NIN;
        {
            const v4u w0 = *(const GAS v4u*)(prow + PC_SQ + 16 * lane), w1 = *(const GAS v4u*)(prow + PC_SQ + 16 * lane + 8);
            float x[16] = {bf_lo(w0.x), bf_hi(w0.x), bf_lo(w0.y), bf_hi(w0.y), bf_lo(w0.z), bf_hi(w0.z), bf_lo(w0.w), bf_hi(w0.w),
                           bf_lo(w1.x), bf_hi(w1.x), bf_lo(w1.y), bf_hi(w1.y), bf_lo(w1.z), bf_hi(w1.z), bf_lo(w1.w), bf_hi(w1.w)};
            float ss = 0.f;
#pragma unroll
            for (int i = 0; i < 16; ++i) ss += x[i] * x[i];
            ss += __shfl_xor(ss, 1); ss += __shfl_xor(ss, 2);
            const float r = 1.0f / sqrtf(ss * (1.0f / 64.0f) + EPS);
            const float* g = L.swa_qn + 16 * (lane & 3);
            v4u o0, o1;
            o0.x = pk2(x[0] * r * g[0], x[1] * r * g[1]); o0.y = pk2(x[2] * r * g[2], x[3] * r * g[3]); o0.z = pk2(x[4] * r * g[4], x[5] * r * g[5]); o0.w = pk2(x[6] * r * g[6], x[7] * r * g[7]);
            o1.x = pk2(x[8] * r * g[8], x[9] * r * g[9]); o1.y = pk2(x[10] * r * g[10], x[11] * r * g[11]); o1.z = pk2(x[12] * r * g[12], x[13] * r * g[13]); o1.w = pk2(x[14] * r * g[14], x[15] * r * g[15]);
            *(GAS v4u*)(SQN + (size_t)m * GWID + 16 * lane) = o0; *(GAS v4u*)(SQN + (size_t)m * GWID + 16 * lane + 8) = o1;
            const unsigned kw = *(const GAS unsigned*)(prow + PC_SK + 2 * lane);
            const float k0 = bf_lo(kw), k1 = bf_hi(kw);
            float ks = k0 * k0 + k1 * k1;
#pragma unroll
            for (int o = 1; o < 32; o <<= 1) ks += __shfl_xor(ks, o);
            const float rk = 1.0f / sqrtf(ks * (1.0f / 64.0f) + EPS);
            const int kc = (2 * lane) & 63;
            *(GAS unsigned*)(SKN + (size_t)m * 128 + 2 * lane) = pk2(k0 * rk * L.swa_kn[kc], k1 * rk * L.swa_kn[kc + 1]);
        }
        for (int h = 0; h < NHEAD; ++h) {
            float acc[3][2] = {{0.f, 0.f}, {0.f, 0.f}, {0.f, 0.f}};
#pragma unroll
            for (int i = 0; i < 4; ++i) {
                const int sp = s - 3 + i;
                if (sp >= 0) {
                    const bf16* pr = prow - (size_t)(3 - i) * NIN;
#pragma unroll
                    for (int t = 0; t < 3; ++t) {
                        const int c = t * GWID + h * HD + 2 * lane;
                        const unsigned w = *(const GAS unsigned*)(pr + PC_GQ + c);
                        const float cw0 = L.gdn_conv[i * 3 * GWID + c], cw1 = L.gdn_conv[i * 3 * GWID + c + 1];
                        acc[t][0] += bf_lo(w) * cw0; acc[t][1] += bf_hi(w) * cw1;
                    }
                }
            }
#pragma unroll
            for (int t = 0; t < 3; ++t) { acc[t][0] = silu_f(acc[t][0]); acc[t][1] = silu_f(acc[t][1]); }
            const float rq = 1.0f / sqrtf(wave_sum(acc[0][0] * acc[0][0] + acc[0][1] * acc[0][1]) + EPS);
            const float rk = 1.0f / sqrtf(wave_sum(acc[1][0] * acc[1][0] + acc[1][1] * acc[1][1]) + EPS);
            const size_t o = (size_t)m * GWID + h * HD + 2 * lane;
            *(GAS unsigned*)(GQ + o) = pk2(acc[0][0] * rq, acc[0][1] * rq);
            *(GAS unsigned*)(GK + o) = pk2(acc[1][0] * rk, acc[1][1] * rk);
            *(GAS unsigned*)(GV + o) = pk2(acc[2][0], acc[2][1]);
        }
        if (lane < NHEAD) {
            const float ga = bf1(prow[PC_GA + lane]), gb = bf1(prow[PC_GB + lane]);
            const float xx = ga + L.gdn_dtb[lane];
            const float sp = xx > 20.0f ? xx : log1pf(expf(xx));
            GG[(size_t)m * NHEAD + lane] = -expf(L.gdn_alog[lane]) * sp;
            GBETA[(size_t)m * NHEAD + lane] = 1.0f / (1.0f + expf(-gb));
        }
        {
            float cacc[16];
#pragma unroll
            for (int i = 0; i < 16; ++i) cacc[i] = 0.f;
#pragma unroll
            for (int i = 0; i < 3; ++i) {
                const int sp = s - 2 + i;
                if (sp >= 0) {
                    const bf16* pr = prow - (size_t)(2 - i) * NIN;
#pragma unroll
                    for (int hlf = 0; hlf < 2; ++hlf) {
                        const v4u cw = *(const GAS v4u*)(pr + PC_SCC + 16 * lane + 8 * hlf), xw = *(const GAS v4u*)(pr + PC_SCX + 16 * lane + 8 * hlf);
                        const float* wv = L.sc_conv + i * GWID + 16 * lane + 8 * hlf;
                        const unsigned cws[4] = {cw.x, cw.y, cw.z, cw.w}, xws[4] = {xw.x, xw.y, xw.z, xw.w};
#pragma unroll
                        for (int j = 0; j < 4; ++j) { cacc[8 * hlf + 2 * j] += bf_lo(cws[j]) * bf_lo(xws[j]) * wv[2 * j]; cacc[8 * hlf + 2 * j + 1] += bf_hi(cws[j]) * bf_hi(xws[j]) * wv[2 * j + 1]; }
                    }
                }
            }
#pragma unroll
            for (int hlf = 0; hlf < 2; ++hlf) {
                const v4u bw = *(const GAS v4u*)(prow + PC_SCB + 16 * lane + 8 * hlf);
                v4u o; o.x = pk2(bf_lo(bw.x) * cacc[8 * hlf + 0], bf_hi(bw.x) * cacc[8 * hlf + 1]); o.y = pk2(bf_lo(bw.y) * cacc[8 * hlf + 2], bf_hi(bw.y) * cacc[8 * hlf + 3]);
                o.z = pk2(bf_lo(bw.z) * cacc[8 * hlf + 4], bf_hi(bw.z) * cacc[8 * hlf + 5]); o.w = pk2(bf_lo(bw.w) * cacc[8 * hlf + 6], bf_hi(bw.w) * cacc[8 * hlf + 7]);
                *(GAS v4u*)(MIX + (size_t)m * D + MC_C + 16 * lane + 8 * hlf) = o;
            }
        }
    }
}
__device__ __forceinline__ float dot128_row(const bf16* krow, const LAS float* q) {
    float s0 = 0.f, s1 = 0.f;
#pragma unroll 4
    for (int c = 0; c < 16; ++c) { const v4u w = *(const GAS v4u*)(krow + 8 * c); const f32x4 qa = *(const LAS f32x4*)(q + 8 * c), qb = *(const LAS f32x4*)(q + 8 * c + 4);
        s0 += bf_lo(w.x) * qa.x + bf_lo(w.y) * qa.z + bf_lo(w.z) * qb.x + bf_lo(w.w) * qb.z;
        s1 += bf_hi(w.x) * qa.y + bf_hi(w.y) * qa.w + bf_hi(w.z) * qb.y + bf_hi(w.w) * qb.w; }
    return s0 + s1;
}
__device__ __forceinline__ void moba_task(int m, int h, int lane, unsigned char* ws, LAS float* q  ) {
    const bf16* PROJ = (const bf16*)(ws + WS_PROJ); const bf16* QN = (const bf16*)(ws + WS_QN); const bf16* KN = (const bf16*)(ws + WS_KN); const float* KMEAN = (const float*)(ws + WS_KMEAN);
    bf16* MIX = (bf16*)(ws + WS_MIX);
    const int b = m / SEQ, s = m % SEQ, blk = s / MOBA_BLK;
    { const unsigned w = *(const GAS unsigned*)(QN + (size_t)m * GWID + h * HD + 2 * lane); q[2 * lane] = bf_lo(w); q[2 * lane + 1] = bf_hi(w); }
    LDS_WAIT(); asm volatile("" ::: "memory");
    float gate = -INFINITY;
    if (lane < blk) { const float* km = KMEAN + ((size_t)(b * NHEAD + h) * MOBA_NB + lane) * HD; float g = 0.f;
#pragma unroll 4
        for (int c = 0; c < 32; ++c) { const f32x4 w = *(const GAS f32x4*)(km + 4 * c); const f32x4 qq = *(const LAS f32x4*)(q + 4 * c); g += w.x * qq.x + w.y * qq.y + w.z * qq.z + w.w * qq.w; }
        gate = g; }
    int sel[4];
#pragma unroll
    for (int t = 0; t < 3; ++t) {
        const float best = wave_max(gate);
        const unsigned long long bal = __ballot(gate == best && best > -INFINITY);
        int idx = -1;
        if (bal != 0ull) { idx = __builtin_ctzll(bal); }
        sel[t] = idx;
        if (lane == idx) gate = -INFINITY;
    }
    sel[3] = blk;
    float sc[4][4];
    float mx = -INFINITY;
#pragma unroll
    for (int t = 0; t < 4; ++t) {
        const int bsel = __builtin_amdgcn_readfirstlane(sel[t]);
#pragma unroll
        for (int r = 0; r < 4; ++r) {
            float v = -INFINITY;
            if (bsel >= 0) { const int kp = bsel * MOBA_BLK + r * 64 + lane;
                if (t < 3 || kp <= s) v = dot128_row(KN + ((size_t)b * SEQ + kp) * GWID + h * HD, q) * 0.08838834764831845f; }
            sc[t][r] = v; mx = fmaxf(mx, v);
        }
    }
    mx = wave_max(mx);
    float sum = 0.f;
#pragma unroll
    for (int t = 0; t < 4; ++t)
#pragma unroll
        for (int r = 0; r < 4; ++r) { const float p = (sc[t][r] == -INFINITY) ? 0.f : __expf(sc[t][r] - mx); sc[t][r] = p; sum += p; }
    sum = wave_sum(sum);
    float o0 = 0.f, o1 = 0.f;
#pragma unroll
    for (int t = 0; t < 4; ++t) {
        const int bsel = __builtin_amdgcn_readfirstlane(sel[t]);
        if (bsel < 0) continue;
#pragma unroll
        for (int r = 0; r < 4; ++r) {
            const bf16* vbase = PROJ + ((size_t)b * SEQ + bsel * MOBA_BLK + r * 64) * NIN + PC_MV + h * HD + 2 * lane;
            const float pr = sc[t][r];
#pragma unroll 8
            for (int j = 0; j < 64; ++j) {
                const float p = __shfl(pr, j);
                const unsigned w = *(const GAS unsigned*)(vbase + (size_t)j * NIN);
                o0 += p * bf_lo(w); o1 += p * bf_hi(w);
            }
        }
    }
    const float inv = 1.0f / sum;
    *(GAS unsigned*)(MIX + (size_t)m * D + MC_A + h * HD + 2 * lane) = pk2(o0 * inv, o1 * inv);
}
__device__ __forceinline__ void swa_task(int m, int hq, int lane, const LayerW& L, unsigned char* ws) {
    const bf16* PROJ = (const bf16*)(ws + WS_PROJ); const bf16* SQN = (const bf16*)(ws + WS_SQN); const bf16* SKN = (const bf16*)(ws + WS_SKN); bf16* MIX = (bf16*)(ws + WS_MIX);
    const int s = m % SEQ, kvh = hq >> 3;
    float q[64];
    { const bf16* qrow = SQN + (size_t)m * GWID + hq * 64;
#pragma unroll
      for (int c = 0; c < 8; ++c) { const v4u w = *(const GAS v4u*)(qrow + 8 * c);
          q[8 * c + 0] = bf_lo(w.x); q[8 * c + 1] = bf_hi(w.x); q[8 * c + 2] = bf_lo(w.y); q[8 * c + 3] = bf_hi(w.y); q[8 * c + 4] = bf_lo(w.z); q[8 * c + 5] = bf_hi(w.z); q[8 * c + 6] = bf_lo(w.w); q[8 * c + 7] = bf_hi(w.w); } }
    float sc[2];
    const float sink = L.swa_sinks[hq];
    float mx = sink;
#pragma unroll
    for (int r = 0; r < 2; ++r) {
        const int d = r * 64 + lane;
        float v = -INFINITY;
        if (d <= s) { const bf16* krow = SKN + (size_t)(m - d) * 128 + kvh * 64; float s0 = 0.f;
#pragma unroll
            for (int c = 0; c < 8; ++c) { const v4u w = *(const GAS v4u*)(krow + 8 * c);
                s0 += bf_lo(w.x) * q[8 * c + 0] + bf_hi(w.x) * q[8 * c + 1] + bf_lo(w.y) * q[8 * c + 2] + bf_hi(w.y) * q[8 * c + 3] + bf_lo(w.z) * q[8 * c + 4] + bf_hi(w.z) * q[8 * c + 5] + bf_lo(w.w) * q[8 * c + 6] + bf_hi(w.w) * q[8 * c + 7]; }
            v = s0 * 0.125f; }
        sc[r] = v; mx = fmaxf(mx, v);
    }
    mx = wave_max(mx);
    float sum = 0.f;
#pragma unroll
    for (int r = 0; r < 2; ++r) { const float p = (sc[r] == -INFINITY) ? 0.f : __expf(sc[r] - mx); sc[r] = p; sum += p; }
    sum = wave_sum(sum) + __expf(sink - mx);
    float o = 0.f;
#pragma unroll
    for (int r = 0; r < 2; ++r) {
        const float pr = sc[r];
#pragma unroll 8
        for (int j = 0; j < 64; ++j) {
            const int d = r * 64 + j;
            if (d > s) break;
            const float p = __shfl(pr, j);
            o += p * bf1(PROJ[(size_t)(m - d) * NIN + PC_SV + kvh * 64 + lane]);
        }
    }
    o *= 1.0f / sum;
    const float on = __shfl_xor(o, 1);
    if ((lane & 1) == 0) *(GAS unsigned*)(MIX + (size_t)m * D + MC_D + hq * 64 + lane) = pk2(o, on);
}
__device__ __forceinline__ void gdn_recurrence_task(int b, int h, int half, int lane, unsigned char* ws, LAS float* kq  ) {
    const bf16* GQ = (const bf16*)(ws + WS_GQ); const bf16* GK = (const bf16*)(ws + WS_GK); const bf16* GV = (const bf16*)(ws + WS_GV);
    const float* GG = (const float*)(ws + WS_GG); const float* GBETA = (const float*)(ws + WS_GBETA); float* GO = (float*)(ws + WS_GO);
    float S[128];
#pragma unroll
    for (int i = 0; i < 128; ++i) S[i] = 0.f;
    const int j = half * 64 + lane;
    const size_t m0 = (size_t)b * SEQ;
    unsigned kw = *(const GAS unsigned*)(GK + m0 * GWID + h * HD + 2 * lane), qw = *(const GAS unsigned*)(GQ + m0 * GWID + h * HD + 2 * lane);
    float vv = bf1(GV[m0 * GWID + h * HD + j]), gg = GG[m0 * NHEAD + h], bb = GBETA[m0 * NHEAD + h];
    for (int t = 0; t < SEQ; ++t) {
        const size_t m = m0 + t;
        kq[2 * lane] = bf_lo(kw); kq[2 * lane + 1] = bf_hi(kw); kq[128 + 2 * lane] = bf_lo(qw); kq[128 + 2 * lane + 1] = bf_hi(qw);
        const float v = vv, alpha = __expf(gg), beta = bb;
        if (t + 1 < SEQ) { const size_t mn = m + 1;
            kw = *(const GAS unsigned*)(GK + mn * GWID + h * HD + 2 * lane); qw = *(const GAS unsigned*)(GQ + mn * GWID + h * HD + 2 * lane);
            vv = bf1(GV[mn * GWID + h * HD + j]); gg = GG[mn * NHEAD + h]; bb = GBETA[mn * NHEAD + h]; }
        LDS_WAIT(); asm volatile("" ::: "memory");
        float ks = 0.f;
#pragma unroll
        for (int c = 0; c < 32; ++c) { const f32x4 k4 = *(const LAS f32x4*)(kq + 4 * c); ks += k4.x * S[4 * c] + k4.y * S[4 * c + 1] + k4.z * S[4 * c + 2] + k4.w * S[4 * c + 3];
            if ((c & 7) == 7) asm volatile("" ::: "memory"); }
        const float cc = beta * (v - alpha * ks);
        float o = 0.f;
#pragma unroll
        for (int c = 0; c < 32; ++c) { const f32x4 k4 = *(const LAS f32x4*)(kq + 4 * c); const f32x4 q4 = *(const LAS f32x4*)(kq + 128 + 4 * c);
            S[4 * c] = alpha * S[4 * c] + k4.x * cc; S[4 * c + 1] = alpha * S[4 * c + 1] + k4.y * cc; S[4 * c + 2] = alpha * S[4 * c + 2] + k4.z * cc; S[4 * c + 3] = alpha * S[4 * c + 3] + k4.w * cc;
            o += q4.x * S[4 * c] + q4.y * S[4 * c + 1] + q4.z * S[4 * c + 2] + q4.w * S[4 * c + 3];
            if ((c & 3) == 3) asm volatile("" ::: "memory"); }
        GO[m * GWID + h * HD + j] = o * 0.08838834764831845f;
        asm volatile("" ::: "memory");
    }
}
__device__ __forceinline__ void phase_mixers_simple(Frame& F, const LayerW& L, unsigned char* ws) {
    const bool gdn_wave = (blockIdx.x < BATCH * NHEAD) && (F.wave < 2);
    if (gdn_wave) {
        __builtin_amdgcn_s_setprio(3);
        gdn_recurrence_task(blockIdx.x / NHEAD, blockIdx.x % NHEAD, F.wave, F.lane, ws, (LAS float*)(F.lds + RING_OFF + F.wave * 1024));
        __builtin_amdgcn_s_setprio(0);
    } else {
        const int ngd = BATCH * NHEAD * 2;
        const int wk = (blockIdx.x < BATCH * NHEAD) ? (blockIdx.x * (NWAVES - 2) + F.wave - 2) : (BATCH * NHEAD * (NWAVES - 2) + (blockIdx.x - BATCH * NHEAD) * NWAVES + F.wave);
        const int NW = F.G * NWAVES - ngd;
        for (int it = wk; it < M * NHEAD; it += NW) moba_task(it / NHEAD, it % NHEAD, F.lane, ws, (LAS float*)(F.lds + RING_OFF + 4096 + F.wave * 512));
        for (int it = wk; it < M * 16; it += NW) swa_task(it / 16, it % 16, F.lane, L, ws);
    }
}
__device__ __forceinline__ void phase_gdn_out(Frame& F, const LayerW& L, unsigned char* ws) {
    const bf16* PROJ = (const bf16*)(ws + WS_PROJ); const float* GO = (const float*)(ws + WS_GO); bf16* MIX = (bf16*)(ws + WS_MIX);
    const int gw = F.vcu * NWAVES + F.wave, NGW = F.G * NWAVES, lane = F.lane;
    const float g0 = L.gdn_onorm[2 * lane], g1 = L.gdn_onorm[2 * lane + 1];
    for (int m = gw; m < M; m += NGW) {
#pragma unroll
        for (int h = 0; h < NHEAD; ++h) {
            const float o0 = GO[(size_t)m * GWID + h * HD + 2 * lane], o1 = GO[(size_t)m * GWID + h * HD + 2 * lane + 1];
            const float r = 1.0f / sqrtf(wave_sum(o0 * o0 + o1 * o1) * (1.0f / HD) + EPS);
            const unsigned zw = *(const GAS unsigned*)(PROJ + (size_t)m * NIN + PC_GZ + h * HD + 2 * lane);
            *(GAS unsigned*)(MIX + (size_t)m * D + MC_B + h * HD + 2 * lane) = pk2(o0 * r * g0 * silu_f(bf_lo(zw)), o1 * r * g1 * silu_f(bf_hi(zw)));
        }
    }
}

#ifndef SKIP_P0
#define SKIP_P0 0
#endif
#ifndef SKIP_P1
#define SKIP_P1 0
#endif
#ifndef SKIP_P2
#define SKIP_P2 0
#endif
#ifndef SKIP_P3
#define SKIP_P3 0
#endif
#ifndef SKIP_P4
#define SKIP_P4 0
#endif
#ifndef SKIP_P5
#define SKIP_P5 0
#endif
#ifndef SKIP_P6
#define SKIP_P6 0
#endif
#ifndef SKIP_P7
#define SKIP_P7 0
#endif
#ifndef SKIP_P8
#define SKIP_P8 0
#endif
struct Args { const float* in[18]; float* out; unsigned char* ws; int ph_lo, ph_hi, li, pad; };
constexpr int PH_PER_LAYER = 9, N_PHASES = DEPTH * PH_PER_LAYER;
#ifndef MK_N_LAUNCHES
#define MK_N_LAUNCHES 1
#endif

__global__ void __launch_bounds__(NWAVES * 64, 2) hymba_fwd(Args args) {
    extern __shared__ __attribute__((aligned(16))) unsigned char lds[];
    Frame F;
    F.lds = (LAS unsigned char*)lds;
    F.MISC = (volatile LAS unsigned*)(F.lds + MISC_OFF);
    F.tid = threadIdx.x; F.lane = F.tid & 63; F.wave = __builtin_amdgcn_readfirstlane(F.tid >> 6);
    F.G = gridDim.x; { const int bx = blockIdx.x; F.vcu = (F.G % 8 == 0) ? (bx % 8) * (F.G / 8) + bx / 8 : bx; }
    F.ctl = (gu32*)(args.ws + WS_CTL);
    for (int u = F.tid; u < (LDS_BYTES - LDSCTL_OFF) / 4; u += NWAVES * 64) ((LAS unsigned*)(F.lds + LDSCTL_OFF))[u] = 0u;
    __syncthreads();
    XcdBarrier bar = xcd_barrier_post((unsigned*)(F.ctl + CW_BAR) + args.li * XCD_BAR_WORDS, F.MISC + 8);
    const int lo = args.ph_lo, hi = args.ph_hi;
#define IN(k) (lo <= (k) && (k) < hi)
#define SEAM(k) do { if (IN(k) && IN((k) + 1)) xcd_barrier(bar); } while (0)

    typedef const __attribute__((address_space(4))) Args* KArgs;
#define PHASE_BEGIN() asm volatile("" : "+v"(F.lane), "+v"(F.tid), "+s"(F.wave), "+s"(F.G), "+s"(F.vcu))
#define KA() ({ PHASE_BEGIN(); KArgs _p = (KArgs)__builtin_amdgcn_kernarg_segment_ptr(); asm volatile("" : "+s"(_p)); _p; })
#define MAKE_L(L, ap, layer) LayerW L; { \
        L.norm_mix = ap->in[1] + (size_t)layer * D; L.w_in = ap->in[2] + (size_t)layer * D * IN_REAL; L.moba_qn = ap->in[3] + layer * HD; L.moba_kn = ap->in[4] + layer * HD; \
        L.gdn_conv = ap->in[5] + (size_t)layer * 4 * 3 * GWID; L.gdn_alog = ap->in[6] + layer * NHEAD; L.gdn_dtb = ap->in[7] + layer * NHEAD; L.gdn_onorm = ap->in[8] + layer * HD; \
        L.sc_conv = ap->in[9] + (size_t)layer * 3 * GWID; L.swa_qn = ap->in[10] + layer * 64; L.swa_kn = ap->in[11] + layer * 64; L.swa_sinks = ap->in[12] + layer * 16; \
        L.w_out = ap->in[13] + (size_t)layer * D * D; L.norm_ffn = ap->in[14] + (size_t)layer * D; L.w_gate = ap->in[15] + (size_t)layer * D * DFF; L.w_up = ap->in[16] + (size_t)layer * D * DFF; \
        L.w_down = ap->in[17] + (size_t)layer * DFF * D; }
    for (int layer = 0; layer < DEPTH; ++layer) {
        const int pb = layer * PH_PER_LAYER;
        if (IN(pb + 0)) if (!SKIP_P0) { KArgs ap = KA(); unsigned char* ws = ap->ws; MAKE_L(L, ap, layer);
            phase_convert_weights(F, L, ws); phase_rmsnorm(F, (layer == 0) ? ap->in[0] : ap->out, L.norm_mix, (bf16*)(ws + WS_H)); }
        SEAM(pb + 0);
        if (IN(pb + 1)) if (!SKIP_P1) { KArgs ap = KA(); unsigned char* ws = ap->ws;
            pg8::Gemm g{(const bf16*)(ws + WS_H), (const bf16*)(ws + WS_WIN), M, NIN, D}; pg8::StaticOrder S; S.init(M, NIN, F.G, (int)blockIdx.x);
            pg8::EpiBf16Plain E{(bf16*)(ws + WS_PROJ), NIN};
            pg8::gemm_phase<pg8::EpiBf16Plain, pg8::StaticOrder, true, true>(F.lds + RING_OFF, g, S, E); }
        SEAM(pb + 1);
        if (IN(pb + 2)) if (!SKIP_P2) { KArgs ap = KA(); unsigned char* ws = ap->ws; MAKE_L(L, ap, layer); phase_prep_moba(F, L, ws); phase_prep_tokens(F, L, ws); }
        SEAM(pb + 2);
        if (IN(pb + 3)) if (!SKIP_P3) { KArgs ap = KA(); unsigned char* ws = ap->ws; MAKE_L(L, ap, layer); phase_mixers_simple(F, L, ws); }
        SEAM(pb + 3);
        if (IN(pb + 4)) if (!SKIP_P4) { KArgs ap = KA(); unsigned char* ws = ap->ws; MAKE_L(L, ap, layer); phase_gdn_out(F, L, ws); }
        SEAM(pb + 4);
        if (IN(pb + 5)) if (!SKIP_P5) { KArgs ap = KA(); unsigned char* ws = ap->ws;
            pg8::Gemm g{(const bf16*)(ws + WS_MIX), (const bf16*)(ws + WS_WOUT), M, D, D}; pg8::StaticOrder S; S.init(M, D, F.G, (int)blockIdx.x);
            pg8::EpiResF32 E{(layer == 0) ? ap->in[0] : ap->out, ap->out, D};
            pg8::gemm_phase<pg8::EpiResF32, pg8::StaticOrder, true, true>(F.lds + RING_OFF, g, S, E); }
        SEAM(pb + 5);
        if (IN(pb + 6)) if (!SKIP_P6) { KArgs ap = KA(); unsigned char* ws = ap->ws; phase_rmsnorm(F, ap->out, ap->in[14] + (size_t)layer * D, (bf16*)(ws + WS_H)); }
        SEAM(pb + 6);
        if (IN(pb + 7)) if (!SKIP_P7) { KArgs ap = KA(); unsigned char* ws = ap->ws;
            pg8::Gemm g{(const bf16*)(ws + WS_H), (const bf16*)(ws + WS_WGU), M, NGU, D}; pg8::StaticOrder S; S.init(M, NGU, F.G, (int)blockIdx.x);
            pg8::EpiSwiGLU E{(bf16*)(ws + WS_ACT), DFF};
            pg8::gemm_phase<pg8::EpiSwiGLU, pg8::StaticOrder, true, true>(F.lds + RING_OFF, g, S, E); }
        SEAM(pb + 7);
        if (IN(pb + 8)) if (!SKIP_P8) { KArgs ap = KA(); unsigned char* ws = ap->ws;
            pg8::Gemm g{(const bf16*)(ws + WS_ACT), (const bf16*)(ws + WS_WDN), M, D, DFF}; pg8::StaticOrder S; S.init(M, D, F.G, (int)blockIdx.x);
            pg8::EpiResF32 E{ap->out, ap->out, D};
            pg8::gemm_phase<pg8::EpiResF32, pg8::StaticOrder, true, true>(F.lds + RING_OFF, g, S, E); }
        SEAM(pb + 8);
    }
#undef IN
#undef SEAM
}

extern "C" void kernel_launch(void* const* d_in, const int* in_sizes, int n_in, void* d_out, int out_size, void* d_ws, size_t ws_size, hipStream_t stream) {
    static int grid = 0;
    if (grid == 0) {
        if (n_in != 18 || in_sizes[0] != M * D || out_size != M * D || ws_size < WS_END) { fprintf(stderr, "kernel_launch: unexpected shapes (n_in %d, in0 %d, out %d, ws %zu); nothing launched\n", n_in, n_in > 0 ? in_sizes[0] : -1, out_size, ws_size); grid = -1; return; }
        int dev = 0, cus = 0, per_cu = 0;
        if (hipGetDevice(&dev) != hipSuccess || hipDeviceGetAttribute(&cus, hipDeviceAttributeMultiprocessorCount, dev) != hipSuccess) { grid = -1; return; }
        if (hipFuncSetAttribute((const void*)hymba_fwd, hipFuncAttributeMaxDynamicSharedMemorySize, LDS_BYTES) != hipSuccess) { fprintf(stderr, "kernel_launch: hipFuncSetAttribute failed\n"); grid = -1; return; }
        if (hipOccupancyMaxActiveBlocksPerMultiprocessor(&per_cu, (const void*)hymba_fwd, NWAVES * 64, LDS_BYTES) != hipSuccess || per_cu < 1)
            fprintf(stderr, "kernel_launch: note: occupancy query reports %d workgroups per CU\n", per_cu);
        (void)hipGetLastError();
        grid = cus;
    }
    if (grid < 0) return;
    if (hipMemsetAsync((char*)d_ws + WS_CTL, 0, CTL_ZERO_BYTES, stream) != hipSuccess) return;
    Args a{};
    for (int i = 0; i < 18; ++i) a.in[i] = (const float*)d_in[i];
    a.out = (float*)d_out; a.ws = (unsigned char*)d_ws; a.pad = 0;
#if MK_N_LAUNCHES == 1
    a.ph_lo = 0; a.ph_hi = N_PHASES; a.li = 0;
    hipLaunchKernelGGL(hymba_fwd, dim3(grid), dim3(NWAVES * 64), LDS_BYTES, stream, a);
#else
    for (int p = 0; p < N_PHASES; ++p) { a.ph_lo = p; a.ph_hi = p + 1; a.li = 0;
        hipLaunchKernelGGL(hymba_fwd, dim3(grid), dim3(NWAVES * 64), LDS_BYTES, stream, a); }
#endif
}
```

```cpp
#include <hip/hip_runtime.h>
#include <cstdio>
#include <cstdint>
#include <cmath>
namespace pg8 {
#define PG8_LAS __attribute__((address_space(3)))
typedef unsigned short bf16_t;
typedef short bf16x8 __attribute__((ext_vector_type(8)));
typedef float f32x4 __attribute__((ext_vector_type(4)));
typedef unsigned u32x4 __attribute__((ext_vector_type(4)));
constexpr int BM = 256, BK = 64, HALF = 128, HTB = HALF * BK * 2  , STAGE_BYTES = 8 * HTB, NXCD = 8, WGM = 8;

__host__ __device__ __forceinline__ int lds_byte(int r, int c) { const int st = (r >> 4) * 2 + (c >> 5), rr = r & 15, cc = c & 31, ob = rr * 64 + cc * 2; return st * 1024 + (ob ^ (((ob >> 9) & 1) << 5)); }
__host__ __device__ __forceinline__ void stage_rc(int b, int& R, int& C) { const int st = b / 1024, sb = b % 1024, swz = sb ^ (((sb >> 9) & 1) << 5); R = (st >> 1) * 16 + swz / 64; C = (st & 1) * 32 + (swz % 64) / 2; }
__host__ __device__ __forceinline__ int perm32(int rho) { const int n = rho >> 4, i = rho & 15; return 8 * (i >> 2) + 4 * n + (i & 3); }

struct Unit { int pm, pn; };
struct Gemm { const bf16_t* A; const bf16_t* Bt; int M, N, K; };

struct StaticOrder {
    int nM, nN, nwg, G, c, wgm;
    __host__ __device__ void init(int M, int N, int G_, int c_, int wgm_ = WGM) { nM = M / BM; nN = N / BM; nwg = nM * nN; G = G_; c = c_; wgm = wgm_; }
    __host__ __device__ bool next(int i, Unit& u) const {
        const long L = (long)i * G + c; if (L >= nwg) return false;
        int wgid = (int)L; { const int q = nwg / NXCD, r = nwg % NXCD, xcd = wgid % NXCD, off = wgid / NXCD; wgid = (xcd < r ? xcd * (q + 1) : r * (q + 1) + (xcd - r) * q) + off; }
        const int nig = wgm * nN, gid = wgid / nig, fm = gid * wgm, gsz = (nM - fm) < wgm ? (nM - fm) : wgm;
        u.pm = fm + ((wgid % nig) % gsz); u.pn = (wgid % nig) / gsz; return true;
    }
    __device__ __forceinline__ void a_ready(const Unit&) const {}
    __device__ __forceinline__ void done(const Unit&) const {}
};

__device__ __forceinline__ unsigned cvt_pk_bf16(float lo, float hi) { unsigned r; asm volatile("v_cvt_pk_bf16_f32 %0, %1, %2" : "=v"(r) : "v"(lo), "v"(hi)); return r; }

struct EpiBf16Plain {
    static constexpr bool PERM = true, AFTER_DRAIN = false;
    bf16_t* O; int ldc; const float* rs;
    __device__ __forceinline__ void operator()(const f32x4 (&acc)[2][2][4][2], const Unit& u, int wr, int wc, int fr, int fq) const {
        const int row0 = u.pm * BM + wr * 64 + fr; const int col0 = u.pn * BM + wc * 32 + 8 * fq;
        float rr[2][4];
#pragma unroll
        for (int ai = 0; ai < 2; ++ai)
#pragma unroll
            for (int m = 0; m < 4; ++m) rr[ai][m] = rs[row0 + ai * HALF + m * 16];
#pragma unroll
        for (int ai = 0; ai < 2; ++ai)
#pragma unroll
            for (int m = 0; m < 4; ++m) { bf16_t* rowp = O + (size_t)(row0 + ai * HALF + m * 16) * ldc + col0; const float r = rr[ai][m];
#pragma unroll
                for (int bj = 0; bj < 2; ++bj) { const f32x4 v0 = acc[ai][bj][m][0] * r, v1 = acc[ai][bj][m][1] * r;
                    u32x4 w; w.x = cvt_pk_bf16(v0[0], v0[1]); w.y = cvt_pk_bf16(v0[2], v0[3]); w.z = cvt_pk_bf16(v1[0], v1[1]); w.w = cvt_pk_bf16(v1[2], v1[3]);
                    *(u32x4*)(rowp + bj * HALF) = w; } }
    }
};
struct EpiResF32 {
    static constexpr bool PERM = false, AFTER_DRAIN = false;
    const float* base; float* C; int ldc; bf16_t* XG; const float* gain; float* RS;
    __device__ __forceinline__ void operator()(const f32x4 (&acc)[2][2][4][2], const Unit& u, int wr, int wc, int fr, int fq) const {
        const int row0 = u.pm * BM + wr * 64 + fr, col0 = u.pn * BM + wc * 32 + 4 * fq;
        f32x4 gv[2][2];
        if (XG) {
#pragma unroll
            for (int bj = 0; bj < 2; ++bj)
#pragma unroll
                for (int n = 0; n < 2; ++n) gv[bj][n] = *(const f32x4*)(gain + col0 + bj * HALF + n * 16);
        }
#pragma unroll
        for (int ai = 0; ai < 2; ++ai)
#pragma unroll
        for (int mh = 0; mh < 2; ++mh) {
            f32x4 bs[2][2][2];
#pragma unroll
            for (int mm = 0; mm < 2; ++mm) { const size_t off = (size_t)(row0 + ai * HALF + (2 * mh + mm) * 16) * ldc + col0;
#pragma unroll
                for (int bj = 0; bj < 2; ++bj)
#pragma unroll
                    for (int n = 0; n < 2; ++n) bs[mm][bj][n] = *(const f32x4*)(base + off + bj * HALF + n * 16); }
#pragma unroll
            for (int mm = 0; mm < 2; ++mm) { const int m = 2 * mh + mm; const int row = row0 + ai * HALF + m * 16; const size_t off = (size_t)row * ldc + col0;
                float ss = 0.f;
#pragma unroll
                for (int bj = 0; bj < 2; ++bj)
#pragma unroll
                    for (int n = 0; n < 2; ++n) { const f32x4 v = acc[ai][bj][m][n] + bs[mm][bj][n]; *(f32x4*)(C + off + bj * HALF + n * 16) = v;
                        if (XG) { ss += (v[0] * v[0] + v[1] * v[1]) + (v[2] * v[2] + v[3] * v[3]); const f32x4 w = v * gv[bj][n];
                            unsigned lo = cvt_pk_bf16(w[0], w[1]), hi = cvt_pk_bf16(w[2], w[3]); *(unsigned long long*)(XG + off + bj * HALF + n * 16) = (unsigned long long)lo | ((unsigned long long)hi << 32); } }
                if (XG) { ss += __shfl_xor(ss, 16); ss += __shfl_xor(ss, 32); if (fq == 0) RS[(size_t)row * 64 + u.pn * 4 + wc] = ss; }
            }
            asm volatile("" ::: "memory");
        }
    }
};
struct EpiSwiGLU {
    static constexpr bool PERM = true, AFTER_DRAIN = false;
    bf16_t* O; int ldc; const float* rs;
    static __device__ __forceinline__ float sg(float g, float uu) { return g * uu * __builtin_amdgcn_rcpf(1.0f + __expf(-g)); }
    __device__ __forceinline__ void operator()(const f32x4 (&acc)[2][2][4][2], const Unit& u, int wr, int wc, int fr, int fq) const {
        const int row0 = u.pm * BM + wr * 64 + fr; const int col0 = u.pn * HALF + wc * 32 + 8 * fq;
        float rr[2][4];
#pragma unroll
        for (int ai = 0; ai < 2; ++ai)
#pragma unroll
            for (int m = 0; m < 4; ++m) rr[ai][m] = rs[row0 + ai * HALF + m * 16];
#pragma unroll
        for (int ai = 0; ai < 2; ++ai)
#pragma unroll
            for (int m = 0; m < 4; ++m) { bf16_t* rowp = O + (size_t)(row0 + ai * HALF + m * 16) * ldc + col0;
                const float r = rr[ai][m];
                const f32x4 g0 = acc[ai][0][m][0] * r, g1 = acc[ai][0][m][1] * r, u0 = acc[ai][1][m][0] * r, u1 = acc[ai][1][m][1] * r;
                u32x4 w; w.x = cvt_pk_bf16(sg(g0[0], u0[0]), sg(g0[1], u0[1])); w.y = cvt_pk_bf16(sg(g0[2], u0[2]), sg(g0[3], u0[3]));
                w.z = cvt_pk_bf16(sg(g1[0], u1[0]), sg(g1[1], u1[1])); w.w = cvt_pk_bf16(sg(g1[2], u1[2]), sg(g1[3], u1[3]));
                *(u32x4*)rowp = w; }
    }
};

template <class Epi, class Sched, bool ALIGN_EPI = false, bool SP2 = false>
__device__ __forceinline__ void gemm_phase(PG8_LAS unsigned char* lds, const Gemm g, const Sched& S, const Epi& E) {
    int tid_ = threadIdx.x; asm volatile("" : "+v"(tid_));
    const int tid = tid_, wid = __builtin_amdgcn_readfirstlane(tid >> 6), lane = tid & 63, wr = wid >> 2, wc = wid & 3, fr = lane & 15, fq = lane >> 4;
    const int K = g.K, nt = K / BK;
    unsigned voffA[2], voffB[2];
#pragma unroll
    for (int i = 0; i < 2; ++i) { int R, C; stage_rc(tid * 16 + i * 8192, R, C); const int Rb = Epi::PERM ? ((R & ~31) + perm32(R & 31)) : R;
        voffA[i] = (unsigned)(R * K + C) * 2u; voffB[i] = (unsigned)(Rb * K + C) * 2u; }
    const size_t kstep = (size_t)(BK * 2);
    const size_t hstep = (size_t)HALF * K * 2;
    const size_t tstep = 2 * hstep;
    const unsigned ldsw = (unsigned)wid * 1024u;
    const int aoff = lds_byte(wr * 64 + fr, fq * 8), boff = lds_byte(wc * 32 + fr, fq * 8);
#define PG8_SA(b, h) (((b) * 2 + (h)) * HTB)
#define PG8_SB(b, h) ((4 + (b) * 2 + (h)) * HTB)
#define PG8_STAGE(bufoff, gbase, voff) do { _Pragma("unroll") for (int _i = 0; _i < 2; ++_i) \
        __builtin_amdgcn_global_load_lds((const unsigned*)((const char*)(gbase) + (voff)[_i]), (PG8_LAS unsigned*)(lds + (bufoff) + ldsw + _i * 8192), 16, 0, 0); } while (0)
#define PG8_LDA(dst, b, h) do { _Pragma("unroll") for (int m = 0; m < 4; ++m) _Pragma("unroll") for (int k = 0; k < 2; ++k) dst[m][k] = *(const PG8_LAS bf16x8*)(lds + PG8_SA(b, h) + aoff + m * 2048 + k * 1024); } while (0)
#define PG8_LDB(dst, b, h) do { _Pragma("unroll") for (int n = 0; n < 2; ++n) _Pragma("unroll") for (int k = 0; k < 2; ++k) dst[n][k] = *(const PG8_LAS bf16x8*)(lds + PG8_SB(b, h) + boff + n * 2048 + k * 1024); } while (0)
#define PG8_MMA(ai, bj, At, Bt) do { __builtin_amdgcn_s_setprio(1); _Pragma("unroll") for (int m = 0; m < 4; ++m) _Pragma("unroll") for (int n = 0; n < 2; ++n) _Pragma("unroll") for (int k = 0; k < 2; ++k) \
        acc[ai][bj][m][n] = __builtin_amdgcn_mfma_f32_16x16x32_bf16(Bt[n][k], At[m][k], acc[ai][bj][m][n], 0, 0, 0); __builtin_amdgcn_s_setprio(0); } while (0)
#define PG8_WAIT_V(n) asm volatile("s_waitcnt vmcnt(" #n ")" ::: "memory")
#define PG8_WAIT_L(n) asm volatile("s_waitcnt lgkmcnt(" #n ")" ::: "memory")
#define PG8_BAR __builtin_amdgcn_s_barrier()
#define PG8_SCHED __builtin_amdgcn_sched_barrier(0)
    Unit cur, nxt; int ui = 0;
    if (!S.next(0, cur)) return;
    f32x4 acc[2][2][4][2];
#pragma unroll
    for (int a = 0; a < 2; ++a)
#pragma unroll
        for (int b = 0; b < 2; ++b)
#pragma unroll
            for (int m = 0; m < 4; ++m)
#pragma unroll
                for (int n = 0; n < 2; ++n) acc[a][b][m][n] = (f32x4){0.f, 0.f, 0.f, 0.f};
    bf16x8 At[4][2], B0[2][2], B1[2][2];
    const char* cA = (const char*)g.A + (size_t)cur.pm * tstep; const char* cB = (const char*)g.Bt + (size_t)cur.pn * tstep;
    S.a_ready(cur);
    if constexpr (SP2) {
        PG8_STAGE(PG8_SB(0, 0), cB, voffB); PG8_STAGE(PG8_SB(0, 1), cB + hstep, voffB); PG8_STAGE(PG8_SA(0, 0), cA, voffA); PG8_STAGE(PG8_SA(0, 1), cA + hstep, voffA);
        if (wr == 1) PG8_BAR;
        PG8_WAIT_V(2); PG8_BAR;
        PG8_STAGE(PG8_SB(1, 0), cB + kstep, voffB); PG8_STAGE(PG8_SA(1, 0), cA + kstep, voffA); PG8_STAGE(PG8_SB(1, 1), cB + hstep + kstep, voffB);
        PG8_WAIT_V(6); PG8_BAR;
    } else {
        PG8_STAGE(PG8_SB(0, 0), cB, voffB); PG8_STAGE(PG8_SA(0, 0), cA, voffA); PG8_STAGE(PG8_SB(0, 1), cB + hstep, voffB); PG8_STAGE(PG8_SA(0, 1), cA + hstep, voffA);
        if (wr == 1) PG8_BAR;
        PG8_WAIT_V(4); PG8_BAR;
        PG8_STAGE(PG8_SB(1, 0), cB + kstep, voffB); PG8_STAGE(PG8_SA(1, 0), cA + kstep, voffA); PG8_STAGE(PG8_SB(1, 1), cB + hstep + kstep, voffB);
        PG8_WAIT_V(6); PG8_BAR;
    }
    for (;;) {
        const bool has_next = S.next(ui + 1, nxt);
        const char* nA = has_next ? (const char*)g.A + (size_t)nxt.pm * tstep : cA; const char* nB = has_next ? (const char*)g.Bt + (size_t)nxt.pn * tstep : cB;
        for (int t = 0; t < nt; t += 2) {
            const bool last = (t == nt - 2);
            const char* a1 = cA + (size_t)(t + 1) * kstep;
            const char* a2 = last ? nA : cA + (size_t)(t + 2) * kstep; const char* b2 = last ? nB : cB + (size_t)(t + 2) * kstep;
            const char* a3 = a2 + kstep; const char* b3 = b2 + kstep;
            if (last && has_next) S.a_ready(nxt);
            if constexpr (SP2) {
            PG8_LDB(B0, 0, 0); PG8_LDB(B1, 0, 1); PG8_SCHED; PG8_LDA(At, 0, 0); PG8_STAGE(PG8_SA(1, 1), a1 + hstep, voffA);
            PG8_WAIT_V(8); PG8_WAIT_L(0); PG8_BAR; PG8_MMA(0, 0, At, B0); PG8_MMA(0, 1, At, B1); PG8_BAR; PG8_SCHED;
            PG8_LDA(At, 0, 1); PG8_STAGE(PG8_SB(0, 0), b2, voffB); PG8_STAGE(PG8_SB(0, 1), b2 + hstep, voffB); PG8_STAGE(PG8_SA(0, 0), a2, voffA);
            PG8_WAIT_V(8); PG8_WAIT_L(0); PG8_BAR; PG8_MMA(1, 0, At, B0); PG8_MMA(1, 1, At, B1); PG8_BAR; PG8_SCHED;
            PG8_LDB(B0, 1, 0); PG8_LDB(B1, 1, 1); PG8_SCHED; PG8_LDA(At, 1, 0); PG8_STAGE(PG8_SA(0, 1), a2 + hstep, voffA);
            PG8_WAIT_V(8); PG8_WAIT_L(0); PG8_BAR; PG8_MMA(0, 0, At, B0); PG8_MMA(0, 1, At, B1); PG8_BAR; PG8_SCHED;
            PG8_LDA(At, 1, 1); PG8_STAGE(PG8_SB(1, 0), b3, voffB); PG8_STAGE(PG8_SB(1, 1), b3 + hstep, voffB); PG8_STAGE(PG8_SA(1, 0), a3, voffA);
            PG8_WAIT_V(8); PG8_WAIT_L(0); PG8_BAR; PG8_MMA(1, 0, At, B0); PG8_MMA(1, 1, At, B1); PG8_BAR; PG8_SCHED;
            } else {
            PG8_LDB(B0, 0, 0); PG8_SCHED; PG8_LDA(At, 0, 0); PG8_STAGE(PG8_SA(1, 1), a1 + hstep, voffA);
            PG8_WAIT_L(8); PG8_BAR; PG8_WAIT_L(0); PG8_MMA(0, 0, At, B0); PG8_BAR; PG8_SCHED;
            PG8_LDB(B1, 0, 1); PG8_STAGE(PG8_SB(0, 0), b2, voffB);
            PG8_BAR; PG8_WAIT_L(0); PG8_MMA(0, 1, At, B1); PG8_BAR;
            PG8_LDA(At, 0, 1); PG8_STAGE(PG8_SA(0, 0), a2, voffA);
            PG8_BAR; PG8_WAIT_L(0); PG8_MMA(1, 0, At, B0); PG8_BAR; PG8_SCHED;
            PG8_STAGE(PG8_SB(0, 1), b2 + hstep, voffB);
            PG8_WAIT_V(6); PG8_BAR; PG8_MMA(1, 1, At, B1); PG8_BAR;
            PG8_LDB(B0, 1, 0); PG8_SCHED; PG8_LDA(At, 1, 0); PG8_STAGE(PG8_SA(0, 1), a2 + hstep, voffA);
            PG8_WAIT_L(8); PG8_BAR; PG8_WAIT_L(0); PG8_MMA(0, 0, At, B0); PG8_BAR; PG8_SCHED;
            PG8_LDB(B1, 1, 1); PG8_STAGE(PG8_SB(1, 0), b3, voffB);
            PG8_BAR; PG8_WAIT_L(0); PG8_MMA(0, 1, At, B1); PG8_BAR;
            PG8_LDA(At, 1, 1); PG8_STAGE(PG8_SA(1, 0), a3, voffA);
            PG8_BAR; PG8_WAIT_L(0); PG8_MMA(1, 0, At, B0); PG8_BAR; PG8_SCHED;
            PG8_STAGE(PG8_SB(1, 1), b3 + hstep, voffB);
            PG8_WAIT_V(6); PG8_BAR; PG8_MMA(1, 1, At, B1); PG8_BAR;
            }
        }
        if constexpr (ALIGN_EPI) { if (wr == 0) PG8_BAR; }
        if constexpr (!Epi::AFTER_DRAIN) { E(acc, cur, wr, wc, fr, fq); S.done(cur); }
        if (!has_next) break;
#pragma unroll
        for (int a = 0; a < 2; ++a)
#pragma unroll
            for (int b = 0; b < 2; ++b)
#pragma unroll
                for (int m = 0; m < 4; ++m)
#pragma unroll
                    for (int n = 0; n < 2; ++n) acc[a][b][m][n] = (f32x4){0.f, 0.f, 0.f, 0.f};
        cur = nxt; cA = nA; cB = nB; ++ui;
        if constexpr (ALIGN_EPI) { if (wr == 1) PG8_BAR; }
    }
    PG8_WAIT_V(0);
    if constexpr (!ALIGN_EPI) { if (wr == 0) PG8_BAR; }
    PG8_BAR;
    if constexpr (Epi::AFTER_DRAIN) { E.fused(acc, cur, wr, wc, fr, fq, lds, wid, lane); S.done(cur); }
#undef PG8_SA
#undef PG8_SB
#undef PG8_STAGE
#undef PG8_LDA
#undef PG8_LDB
#undef PG8_MMA
#undef PG8_WAIT_V
#undef PG8_WAIT_L
#undef PG8_BAR
#undef PG8_SCHED
}
}
#define GAS __attribute__((address_space(1)))
#define LAS __attribute__((address_space(3)))
typedef unsigned short bf16;
typedef unsigned v4u __attribute__((ext_vector_type(4)));
typedef float f32x4 __attribute__((ext_vector_type(4)));
typedef short bf16x8 __attribute__((ext_vector_type(8)));
typedef GAS unsigned gu32;
typedef GAS unsigned long long gu64;
#define RLX_AGENT __ATOMIC_RELAXED, __HIP_MEMORY_SCOPE_AGENT
#define LDS_WAIT() asm volatile("s_waitcnt lgkmcnt(0)" ::: "memory")
#define VM_WAIT() asm volatile("s_waitcnt vmcnt(0)" ::: "memory")
__device__ __forceinline__ unsigned long long rt() { return __builtin_amdgcn_s_memrealtime(); }
__device__ __forceinline__ unsigned f2bf(float f) { unsigned u = __builtin_bit_cast(unsigned, f); return (u + 0x7fffu + ((u >> 16) & 1u)) >> 16; }
__device__ __forceinline__ unsigned pk2(float lo, float hi) { return f2bf(lo) | (f2bf(hi) << 16); }
typedef float f32x2_t_ __attribute__((ext_vector_type(2))); typedef __bf16 bf16x2_t_ __attribute__((ext_vector_type(2)));
__device__ __forceinline__ unsigned pk2c(float lo, float hi) { const f32x2_t_ v = {lo, hi}; return __builtin_bit_cast(unsigned, __builtin_convertvector(v, bf16x2_t_)); }

#define XB_TMO      128
#define XB_XCNT(j)  (256  + 64 * (j))
#define XB_XSUB(j)  (1280 + 64 * (j))
#define XB_XGEN(j)  (2304 + 64 * (j))
#define XB_TOP      3328
#define XB_TOPGEN   3392
#define XCD_BAR_WORDS 3456
#define XB_SPIN_CAP (1u << 21)

__device__ __forceinline__ unsigned xb_ld(unsigned* p)              { return __hip_atomic_load(p, __ATOMIC_RELAXED, __HIP_MEMORY_SCOPE_AGENT); }
__device__ __forceinline__ unsigned xb_add(unsigned* p, unsigned v) { return __hip_atomic_fetch_add(p, v, __ATOMIC_RELAXED, __HIP_MEMORY_SCOPE_AGENT); }
__device__ __forceinline__ unsigned xb_xcc_id() { return (unsigned)__builtin_amdgcn_s_getreg((3 << 11) | 20) & 0xFu; }
#define XB_SPIN(cond, bar) do { unsigned _sp = 0; while (cond) { __builtin_amdgcn_s_sleep(1); \
    if ((++_sp & 255u) == 0u) { if (xb_ld(&(bar)[XB_TMO])) break; if (_sp > XB_SPIN_CAP) { atomicAdd(&(bar)[XB_TMO], 1u); break; } } } } while (0)

struct XcdBarrier {
    unsigned* bar; unsigned x;
    volatile LAS unsigned* st;
};

__device__ __forceinline__ XcdBarrier xcd_barrier_post(unsigned* bar, volatile LAS unsigned* st) {
    XcdBarrier b; b.bar = bar; b.x = xb_xcc_id(); b.st = st;
    if (threadIdx.x == 0) (void)xb_add(&bar[XB_XCNT(b.x)], 1u);
    return b;
}
__device__ __forceinline__ void xcd_barrier_complete(unsigned* bar, unsigned x, unsigned& nloc, unsigned& nx) {
    const unsigned G = gridDim.x * gridDim.y * gridDim.z;
    unsigned sum, cnt, mine, sp = 0u;
    for (;;) {
        sum = 0u; cnt = 0u; mine = 0u;
#pragma unroll
        for (unsigned j = 0; j < 16; ++j) { const unsigned c = xb_ld(&bar[XB_XCNT(j)]); sum += c; cnt += (c > 0u) ? 1u : 0u; mine = (j == x) ? c : mine; }
        if (sum == G) break;
        __builtin_amdgcn_s_sleep(1);
        if ((++sp & 255u) == 0u) { if (xb_ld(&bar[XB_TMO])) break; if (sp > XB_SPIN_CAP) { atomicAdd(&bar[XB_TMO], 1u); break; } }
    }
    nloc = mine > 0u ? mine : 1u; nx = cnt > 0u ? cnt : 1u;
}

__device__ __forceinline__ void xcd_barrier(const XcdBarrier& b) {
    asm volatile("s_waitcnt vmcnt(0)" ::: "memory");
    __syncthreads();
    if (threadIdx.x == 0) {
        unsigned* bar = b.bar;
        __builtin_amdgcn_s_waitcnt(0);
        unsigned nloc = b.st[0], nx = b.st[1];
        if (nloc == 0u) { xcd_barrier_complete(bar, b.x, nloc, nx); b.st[0] = nloc; b.st[1] = nx; }
        const unsigned old = xb_add(&bar[XB_XSUB(b.x)], 1u);
        const unsigned gen = old / nloc;
        if (old + 1u == (gen + 1u) * nloc) {
            __builtin_amdgcn_fence(__ATOMIC_RELEASE, "agent");
            asm volatile("s_waitcnt vmcnt(0)" ::: "memory");
            const unsigned og = xb_add(&bar[XB_TOP], 1u);
            const unsigned tg = og / nx;
            if (og + 1u == (tg + 1u) * nx) xb_add(&bar[XB_TOPGEN], 1u);
            else XB_SPIN(xb_ld(&bar[XB_TOPGEN]) == tg, bar);
            __builtin_amdgcn_fence(__ATOMIC_ACQUIRE, "agent");
            xb_add(&bar[XB_XGEN(b.x)], 1u);
            asm volatile("s_waitcnt vmcnt(0)" ::: "memory");
        } else {
            XB_SPIN(xb_ld(&bar[XB_XGEN(b.x)]) == gen, bar);
            __builtin_amdgcn_fence(__ATOMIC_ACQUIRE, "agent");
            asm volatile("s_waitcnt vmcnt(0)" ::: "memory");
        }
    }
    __syncthreads();
}
constexpr int NWAVES = 8;
constexpr int BATCH = 2, SEQ = 8192, M = BATCH * SEQ, D = 4096, DEPTH = 2;
constexpr int GWID = 1024, HD = 128, NHEAD = 8;
constexpr int IN_REAL = 11536, NIN = 11776, DFF = 11008, NGU = 2 * DFF;
constexpr float EPS = 1e-6f;
constexpr int PC_MQ = 0, PC_MK = 1024, PC_MV = 2048, PC_GQ = 3072, PC_GK = 4096, PC_GV = 5120, PC_GZ = 6144, PC_SCB = 7168, PC_SCC = 8192, PC_SCX = 9216,
              PC_SQ = 10240, PC_SK = 11264, PC_SV = 11392, PC_GA = 11520, PC_GB = 11528;
constexpr int MC_A = 0, MC_B = 1024, MC_C = 2048, MC_D = 3072;
constexpr int MOBA_BLK = 256, MOBA_NB = SEQ / MOBA_BLK, SWA_W = 128;

constexpr size_t MiB = 1u << 20;
constexpr size_t WS_CTL = 0, CTL_ZERO_BYTES = 1 * MiB;
constexpr size_t WS_WIN = 2 * MiB, WS_WOUT = 94 * MiB, WS_WGU = 126 * MiB, WS_WDN = 298 * MiB;
constexpr size_t WS_H = 384 * MiB, WS_MIX = 512 * MiB, WS_PROJ = 640 * MiB, WS_ACT = WS_PROJ;
constexpr size_t WS_QN = 1008 * MiB, WS_KN = 1040 * MiB, WS_SQN = 1072 * MiB, WS_SKN = 1104 * MiB, WS_KMEAN = 1108 * MiB;
constexpr size_t WS_GQ = 1110 * MiB, WS_GK = 1142 * MiB, WS_GV = 1174 * MiB, WS_GG = 1206 * MiB, WS_GBETA = WS_GG + 512 * 1024, WS_GO = 1208 * MiB, WS_END = 1272 * MiB;
static_assert(WS_WIN + (size_t)NIN * D * 2 <= WS_WOUT && WS_WOUT + (size_t)D * D * 2 <= WS_WGU && WS_WGU + (size_t)NGU * D * 2 <= WS_WDN && WS_WDN + (size_t)D * DFF * 2 <= WS_H, "weights map");
static_assert(WS_PROJ + (size_t)M * NIN * 2 <= WS_QN && WS_GO + (size_t)M * GWID * 4 <= WS_END, "ws map");
constexpr int CW_BAR = 4096;
constexpr size_t WS_RS = 1456 * MiB, WS_RSTD = 1460 * MiB, WS_END4 = 1461 * MiB;
constexpr size_t WS_VTG = 1420 * MiB, WS_SVT = 1452 * MiB, WS_END3 = 1456 * MiB;

constexpr int RING_OFF = 0, RING_BYTES = 131072;
constexpr int LDSCTL_OFF = RING_BYTES, MISC_OFF = LDSCTL_OFF + 320;
constexpr int LDS_BYTES = 147456;

struct Frame {
    LAS unsigned char* lds;
    volatile LAS unsigned* MISC;
    gu32* ctl;
    int tid, lane, wave;
    int vcu, G;
};

__device__ __forceinline__ float wave_sum(float v) {
#pragma unroll
    for (int o = 1; o < 64; o <<= 1) v += __shfl_xor(v, o);
    return v;
}
__device__ __forceinline__ float wave_max(float v) {
#pragma unroll
    for (int o = 1; o < 64; o <<= 1) v = fmaxf(v, __shfl_xor(v, o));
    return v;
}
__device__ __forceinline__ float bf_lo(unsigned w) { return __builtin_bit_cast(float, w << 16); }
__device__ __forceinline__ float bf_hi(unsigned w) { return __builtin_bit_cast(float, w & 0xffff0000u); }
__device__ __forceinline__ float bf1(bf16 h) { return __builtin_bit_cast(float, ((unsigned)h) << 16); }
__device__ __forceinline__ float silu_f(float x) { return x / (1.0f + __expf(-x)); }

template <class SrcCol>
__device__ __forceinline__ void transpose_item(const float* W, int K, int N, bf16* WT, LAS float* scr, int kb, int nb, int lane, SrcCol srcCol) {
    const int k0 = 64 * kb, n0 = 32 * nb;
    const int c4 = (lane & 7) * 4, sc = srcCol(n0 + c4);
    f32x4 v[8];
#pragma unroll
    for (int i = 0; i < 8; ++i) { const int kk = 8 * i + (lane >> 3); v[i] = (sc >= 0) ? *(const GAS f32x4*)(W + (size_t)(k0 + kk) * N + sc) : (f32x4){0.f, 0.f, 0.f, 0.f}; }
#pragma unroll
    for (int i = 0; i < 8; ++i) { const int kk = 8 * i + (lane >> 3); LAS float* d = scr + kk * 33 + c4; d[0] = v[i].x; d[1] = v[i].y; d[2] = v[i].z; d[3] = v[i].w; }
    LDS_WAIT(); asm volatile("" ::: "memory");
    const int c = lane & 7;
#pragma unroll
    for (int j = 0; j < 4; ++j) { const int n = (lane >> 3) + 8 * j; const LAS float* s = scr + (8 * c) * 33 + n;
        v4u o; o.x = pk2(s[0 * 33], s[1 * 33]); o.y = pk2(s[2 * 33], s[3 * 33]); o.z = pk2(s[4 * 33], s[5 * 33]); o.w = pk2(s[6 * 33], s[7 * 33]);
        *(GAS v4u*)(WT + (size_t)(n0 + n) * K + k0 + 8 * c) = o; }
    LDS_WAIT(); asm volatile("" ::: "memory");
}

struct LayerW {
    const float *norm_mix, *w_in, *moba_qn, *moba_kn, *gdn_conv, *gdn_alog, *gdn_dtb, *gdn_onorm, *sc_conv, *swa_qn, *swa_kn, *swa_sinks, *w_out, *norm_ffn, *w_gate, *w_up, *w_down;
};

__device__ __forceinline__ void phase_convert_weights(Frame& F, const LayerW& L, unsigned char* ws) {
    LAS float* scr = (LAS float*)(F.lds + RING_OFF + F.wave * 16384);
    const int gw = F.vcu * NWAVES + F.wave, NGW = F.G * NWAVES;
    constexpr int I_IN = (D / 64) * (NIN / 32), I_OUT = (D / 64) * (D / 32), I_GU = (D / 64) * (NGU / 32), I_DN = (DFF / 64) * (D / 32);
    constexpr int NITEMS = I_IN + I_OUT + I_GU + I_DN;
    bf16* WIN = (bf16*)(ws + WS_WIN); bf16* WOUT = (bf16*)(ws + WS_WOUT); bf16* WGU = (bf16*)(ws + WS_WGU); bf16* WDN = (bf16*)(ws + WS_WDN);
    for (int it = gw; it < NITEMS; it += NGW) {
        int r = it;
        if (r < I_IN) { const int nblk = NIN / 32, kb = r / nblk, nb = r % nblk;
            transpose_item(L.w_in, D, IN_REAL, WIN, scr, kb, nb, F.lane, [](int d) { return d < 6144 ? d : (d < 11520 ? d + 16 : (d < 11536 ? d - 11520 + 6144 : -1)); }); continue; }
        r -= I_IN;
        if (r < I_OUT) { const int nblk = D / 32, kb = r / nblk, nb = r % nblk;
            transpose_item(L.w_out, D, D, WOUT, scr, kb, nb, F.lane, [](int d) { return d; }); continue; }
        r -= I_OUT;
        if (r < I_GU) { const int nblk = NGU / 32, kb = r / nblk, nb = r % nblk; const int row0 = nb * 32; const bool up = (row0 & 255) >= 128;
            transpose_item(up ? L.w_up : L.w_gate, D, DFF, WGU, scr, kb, nb, F.lane, [](int d) { return (d >> 8) * 128 + (d & 127); }); continue; }
        r -= I_GU;
        { const int nblk = D / 32, kb = r / nblk, nb = r % nblk;
            transpose_item(L.w_down, DFF, D, WDN, scr, kb, nb, F.lane, [](int d) { return d; }); }
    }
}

__device__ __forceinline__ void phase_rmsnorm(Frame& F, const float* X, const float* gain, bf16* O, float* RSTD) {
    const int gw = F.vcu * NWAVES + F.wave, NGW = F.G * NWAVES;
    for (int m = gw; m < M; m += NGW) {
        const GAS f32x4* xr = (const GAS f32x4*)(X + (size_t)m * D) + F.lane;
        f32x4 v[16]; float s = 0.f;
#pragma unroll
        for (int j = 0; j < 16; ++j) { v[j] = xr[64 * j]; s += (v[j].x * v[j].x + v[j].y * v[j].y) + (v[j].z * v[j].z + v[j].w * v[j].w); }
        const float rstd = 1.0f / sqrtf(wave_sum(s) * (1.0f / D) + EPS);
        GAS unsigned long long* o8 = (GAS unsigned long long*)(O + (size_t)m * D) + F.lane;
        const GAS f32x4* gr = (const GAS f32x4*)gain + F.lane;
#pragma unroll
        for (int j = 0; j < 16; ++j) { const f32x4 g = gr[64 * j];
            o8[64 * j] = (unsigned long long)pk2(v[j].x * g.x, v[j].y * g.y) | ((unsigned long long)pk2(v[j].z * g.z, v[j].w * g.w) << 32); }
        if (F.lane == 0) RSTD[m] = rstd;
    }
}


__device__ __forceinline__ void phase_rstd(Frame& F, const float* RS, float* RSTD) {
    for (int m = blockIdx.x * (NWAVES * 64) + F.tid; m < M; m += F.G * NWAVES * 64) {
        const GAS f32x4* p = (const GAS f32x4*)(RS + (size_t)m * 64); float s = 0.f;
#pragma unroll
        for (int j = 0; j < 16; ++j) { const f32x4 v = p[j]; s += (v.x + v.y) + (v.z + v.w); }
        RSTD[m] = 1.0f / sqrtf(s * (1.0f / D) + EPS);
    }
}
__device__ __forceinline__ void unpack8(const v4u& w, float (&x)[8]) { x[0] = bf_lo(w.x); x[1] = bf_hi(w.x); x[2] = bf_lo(w.y); x[3] = bf_hi(w.y); x[4] = bf_lo(w.z); x[5] = bf_hi(w.z); x[6] = bf_lo(w.w); x[7] = bf_hi(w.w); }
__device__ __forceinline__ v4u gld16p(const void* base, unsigned off) { return *(const GAS v4u*)((const GAS char*)base + off); }
__device__ __forceinline__ void gst16p(void* base, unsigned off, v4u v) { *(GAS v4u*)((GAS char*)base + off) = v; }
__device__ __forceinline__ float sumsq8(const v4u& w) { float x[8]; unpack8(w, x); return (x[0] * x[0] + x[1] * x[1]) + (x[2] * x[2] + x[3] * x[3]) + (x[4] * x[4] + x[5] * x[5]) + (x[6] * x[6] + x[7] * x[7]); }
__device__ __forceinline__ v4u scale8(const v4u& w, float r, const LAS float* gain) { float x[8]; unpack8(w, x); const f32x4 ga = *(const LAS f32x4*)gain, gb = *(const LAS f32x4*)(gain + 4);
    v4u o; o.x = pk2(x[0] * r * ga.x, x[1] * r * ga.y); o.y = pk2(x[2] * r * ga.z, x[3] * r * ga.w); o.z = pk2(x[4] * r * gb.x, x[5] * r * gb.y); o.w = pk2(x[6] * r * gb.z, x[7] * r * gb.w); return o; }

__device__ __forceinline__ float row16p(float v) {
    v += __builtin_bit_cast(float, __builtin_amdgcn_update_dpp(0, __builtin_bit_cast(int, v), 0xB1, 0xF, 0xF, true));
    v += __builtin_bit_cast(float, __builtin_amdgcn_update_dpp(0, __builtin_bit_cast(int, v), 0x4E, 0xF, 0xF, true));
    v += __builtin_bit_cast(float, __builtin_amdgcn_update_dpp(0, __builtin_bit_cast(int, v), 0x141, 0xF, 0xF, true));
    v += __builtin_bit_cast(float, __builtin_amdgcn_update_dpp(0, __builtin_bit_cast(int, v), 0x140, 0xF, 0xF, true));
    return v;
}
constexpr int PM_PART = 0, PM_TL = 4096, PM_TL2 = PM_TL + 128 * 528, PM_GAIN = PM_TL2 + 64 * 528, PM_END = PM_GAIN + 1024;
static_assert(PM_END <= RING_BYTES && 256 * 272 <= 128 * 528 + 64 * 528, "moba prep LDS map (the K tile may run into TL2: it is dead before TL2 is written)");
__device__ __forceinline__ void phase_prep_moba(Frame& F, const LayerW& L, unsigned char* ws) {
    const bf16* PROJ = (const bf16*)(ws + WS_PROJ); bf16* QN = (bf16*)(ws + WS_QN); bf16* KN = (bf16*)(ws + WS_KN); float* KMEAN = (float*)(ws + WS_KMEAN);
    bf16* VTG = (bf16*)(ws + WS_VTG); bf16* SVT = (bf16*)(ws + WS_SVT);
    LAS unsigned char* LB = F.lds + RING_OFF;
    LAS float* part = (LAS float*)(LB + PM_PART);
    LAS unsigned char* TL = LB + PM_TL; LAS unsigned char* TL2 = LB + PM_TL2;
    LAS float* gain = (LAS float*)(LB + PM_GAIN);
    if (F.tid < 128) gain[F.tid] = L.moba_qn[F.tid]; else if (F.tid < 256) gain[F.tid] = L.moba_kn[F.tid - 128];
    __syncthreads();
    for (int u = blockIdx.x; u < BATCH * MOBA_NB * NHEAD; u += F.G) {
        int tid = F.tid; asm volatile("" : "+v"(tid));
        const int lane = tid & 63, wv = tid >> 6;
        const int h = u % NHEAD, n = (u / NHEAD) % MOBA_NB, b = u / (NHEAD * MOBA_NB);
        const size_t mb = (size_t)b * SEQ + (size_t)n * MOBA_BLK;
        const bf16* pbase = PROJ + mb * NIN + h * HD;
        const int c16 = lane & 15, tq = lane >> 4, tk0 = 32 * wv + tq;
        const unsigned loff = (unsigned)((tk0 * NIN + 8 * c16) * 2);
        v4u qv[8], kv[8], vv[8];
#pragma unroll
        for (int i = 0; i < 8; ++i) { const unsigned o = loff + (unsigned)(4 * i * NIN * 2); qv[i] = gld16p(pbase + PC_MQ, o); kv[i] = gld16p(pbase + PC_MK, o); vv[i] = gld16p(pbase + PC_MV, o); }
        v4u sv[4];
        const int c8 = lane & 7, t8 = lane >> 3;
        if (h < 2) {
#pragma unroll
            for (int i = 0; i < 4; ++i) sv[i] = gld16p(PROJ + mb * NIN + PC_SV + h * 64, (unsigned)(((32 * wv + 8 * i + t8) * NIN + 8 * c8) * 2));
        }
        const unsigned ooff = (unsigned)((tk0 * GWID + 8 * c16) * 2);
#pragma unroll
        for (int i = 0; i < 8; ++i) {
            const float sq = row16p(sumsq8(qv[i])), sk = row16p(sumsq8(kv[i]));
            const float rq = 1.0f / sqrtf(sq * (1.0f / HD) + EPS), rk = 1.0f / sqrtf(sk * (1.0f / HD) + EPS);
            const unsigned o = ooff + (unsigned)(4 * i * GWID * 2);
            gst16p(QN + mb * GWID + h * HD, o, scale8(qv[i], rq, gain + 8 * c16));
            const v4u kn = scale8(kv[i], rk, gain + 128 + 8 * c16);
            gst16p(KN + mb * GWID + h * HD, o, kn);
            *(LAS v4u*)(TL + (tk0 + 4 * i) * 272 + 16 * c16) = kn;
        }
        __syncthreads();
        {
            const int ch = tid & 127, qr = tid >> 7; float s = 0.f;
#pragma unroll 8
            for (int t = 0; t < 64; ++t) s += bf1(*(const LAS unsigned short*)(TL + (64 * qr + t) * 272 + ch * 2));
            part[qr * 128 + ch] = s;
        }
        __syncthreads();
        if (tid < 128) KMEAN[((size_t)(b * NHEAD + h) * MOBA_NB + n) * HD + tid] = ((part[tid] + part[128 + tid]) + (part[256 + tid] + part[384 + tid])) * (1.0f / MOBA_BLK);
#pragma unroll
        for (int i = 0; i < 8; ++i) { const unsigned w4[4] = {vv[i].x, vv[i].y, vv[i].z, vv[i].w}; const int tk = tk0 + 4 * i;
            LAS unsigned char* col = TL + (((tk >> 3) ^ c16) * 16) + (tk & 7) * 2;
#pragma unroll
            for (int e = 0; e < 4; ++e) { const int d = 8 * c16 + 2 * e;
                *(LAS unsigned short*)(col + d * 528) = (unsigned short)(w4[e] & 0xffffu); *(LAS unsigned short*)(col + (d + 1) * 528) = (unsigned short)(w4[e] >> 16); } }
        if (h < 2) {
#pragma unroll
            for (int i = 0; i < 4; ++i) { const unsigned w4[4] = {sv[i].x, sv[i].y, sv[i].z, sv[i].w}; const int tk = 32 * wv + 8 * i + t8;
                LAS unsigned char* col = TL2 + (((tk >> 3) ^ c8) * 16) + (tk & 7) * 2;
#pragma unroll
                for (int e = 0; e < 4; ++e) { const int d = 8 * c8 + 2 * e;
                    *(LAS unsigned short*)(col + d * 528) = (unsigned short)(w4[e] & 0xffffu); *(LAS unsigned short*)(col + (d + 1) * 528) = (unsigned short)(w4[e] >> 16); } }
        }
        __syncthreads();
        { const int row = tid >> 2, qq = tid & 3;
          bf16* dst = VTG + ((size_t)(b * NHEAD + h) * HD + row) * SEQ + n * MOBA_BLK + qq * 64;
#pragma unroll
          for (int j = 0; j < 8; ++j) *(GAS v4u*)(dst + 8 * j) = *(const LAS v4u*)(TL + row * 528 + (((qq * 8 + j) ^ ((row >> 3) & 15)) * 16));
          if (h < 2 && tid < 256) { bf16* dst2 = SVT + ((size_t)(b * 2 + h) * 64 + row) * SEQ + n * MOBA_BLK + qq * 64;
#pragma unroll
              for (int j = 0; j < 8; ++j) *(GAS v4u*)(dst2 + 8 * j) = *(const LAS v4u*)(TL2 + row * 528 + (((qq * 8 + j) ^ ((row >> 3) & 7)) * 16)); } }
        __syncthreads();
    }
}

constexpr int PT_SCW = 0, PT_GQ = 12288, PT_GK = PT_GQ + 256;
__device__ __forceinline__ void phase_prep_tokens(Frame& F, const LayerW& L, unsigned char* ws) {
    const bf16* PROJ = (const bf16*)(ws + WS_PROJ); bf16* SQN = (bf16*)(ws + WS_SQN); bf16* SKN = (bf16*)(ws + WS_SKN); bf16* MIX = (bf16*)(ws + WS_MIX);
    LAS unsigned char* LB = F.lds + RING_OFF;
    LAS float* scw = (LAS float*)(LB + PT_SCW); LAS float* gq = (LAS float*)(LB + PT_GQ); LAS float* gk = (LAS float*)(LB + PT_GK);
    for (int i = F.tid; i < 3 * GWID; i += NWAVES * 64) scw[i] = L.sc_conv[i];
    if (F.tid < 64) gq[F.tid] = L.swa_qn[F.tid]; else if (F.tid < 128) gk[F.tid - 64] = L.swa_kn[F.tid - 64];
    __syncthreads();
    const int gw = F.vcu * NWAVES + F.wave, NGW = F.G * NWAVES;
    int lane = F.lane; asm volatile("" : "+v"(lane));
    const unsigned lo16 = (unsigned)lane * 16u;
    for (int m0 = 2 * gw; m0 < M; m0 += 2 * NGW) {
        v4u q0[2][2], kx[2], cc[2][3][2], cx[2][3][2], cb[2][2];
#pragma unroll
        for (int t = 0; t < 2; ++t) {
            const int m = m0 + t, s = m % SEQ;
            const GAS char* row = (const GAS char*)(PROJ + (size_t)m * NIN);
            q0[t][0] = *(const GAS v4u*)(row + PC_SQ * 2 + lo16); q0[t][1] = *(const GAS v4u*)(row + PC_SQ * 2 + 1024 + lo16);
            kx[t] = (lane < 16) ? *(const GAS v4u*)(row + PC_SK * 2 + lo16) : (v4u){0u, 0u, 0u, 0u};
#pragma unroll
            for (int i = 0; i < 3; ++i) {
                const bool ok = (s - 2 + i) >= 0;
                const GAS char* rw = row - (size_t)(2 - i) * (NIN * 2);
#pragma unroll
                for (int hf = 0; hf < 2; ++hf) {
                    cc[t][i][hf] = ok ? *(const GAS v4u*)(rw + PC_SCC * 2 + 1024 * hf + lo16) : (v4u){0u, 0u, 0u, 0u};
                    cx[t][i][hf] = ok ? *(const GAS v4u*)(rw + PC_SCX * 2 + 1024 * hf + lo16) : (v4u){0u, 0u, 0u, 0u}; }
            }
            cb[t][0] = *(const GAS v4u*)(row + PC_SCB * 2 + lo16); cb[t][1] = *(const GAS v4u*)(row + PC_SCB * 2 + 1024 + lo16);
        }
#pragma unroll
        for (int t = 0; t < 2; ++t) {
            const int m = m0 + t;
#pragma unroll
            for (int hf = 0; hf < 2; ++hf) {
                float ss = sumsq8(q0[t][hf]); ss += __shfl_xor(ss, 1); ss += __shfl_xor(ss, 2); ss += __shfl_xor(ss, 4);
                const float r = __builtin_amdgcn_rsqf(ss * (1.0f / 64.0f) + EPS);
                *(GAS v4u*)((GAS char*)(SQN + (size_t)m * GWID) + 1024 * hf + lo16) = scale8(q0[t][hf], r, gq + 8 * (lane & 7));
            }
            { float ss = sumsq8(kx[t]); ss += __shfl_xor(ss, 1); ss += __shfl_xor(ss, 2); ss += __shfl_xor(ss, 4);
              const float r = __builtin_amdgcn_rsqf(ss * (1.0f / 64.0f) + EPS);
              if (lane < 16) *(GAS v4u*)((GAS char*)(SKN + (size_t)m * 128) + lo16) = scale8(kx[t], r, gk + 8 * (lane & 7)); }
#pragma unroll
            for (int hf = 0; hf < 2; ++hf) {
                float acc[8] = {0.f, 0.f, 0.f, 0.f, 0.f, 0.f, 0.f, 0.f};
#pragma unroll
                for (int i = 0; i < 3; ++i) { float a[8], b[8]; unpack8(cc[t][i][hf], a); unpack8(cx[t][i][hf], b);
                    const LAS float* wp = scw + i * GWID + 512 * hf + 8 * lane; const f32x4 wa = *(const LAS f32x4*)wp, wb = *(const LAS f32x4*)(wp + 4);
                    acc[0] += a[0] * b[0] * wa.x; acc[1] += a[1] * b[1] * wa.y; acc[2] += a[2] * b[2] * wa.z; acc[3] += a[3] * b[3] * wa.w;
                    acc[4] += a[4] * b[4] * wb.x; acc[5] += a[5] * b[5] * wb.y; acc[6] += a[6] * b[6] * wb.z; acc[7] += a[7] * b[7] * wb.w; }
                float bx[8]; unpack8(cb[t][hf], bx);
                v4u o; o.x = pk2(bx[0] * acc[0], bx[1] * acc[1]); o.y = pk2(bx[2] * acc[2], bx[3] * acc[3]); o.z = pk2(bx[4] * acc[4], bx[5] * acc[5]); o.w = pk2(bx[6] * acc[6], bx[7] * acc[7]);
                *(GAS v4u*)((GAS char*)(MIX + (size_t)m * D + MC_C) + 1024 * hf + lo16) = o;
            }
        }
    }
}
constexpr int GDN_C = 64, GDN_NCH = SEQ / GDN_C, GDN_NCHUNKS = BATCH * NHEAD * GDN_NCH;
constexpr size_t WS_CH = 1272 * MiB, WS_GL = 1416 * MiB, WS_END2 = 1417 * MiB;
constexpr int CH_BYTES = 73728, CH_WF = 0, CH_QD = 16384, CH_KD = 32768, CH_QK = 49152, CH_UF = 57344, CH_LDS = 57344;
static_assert(WS_CH + (size_t)GDN_NCHUNKS * CH_BYTES <= WS_GL && 2 * CH_LDS + 4096 <= RING_BYTES, "chunk records");
constexpr int PL_KR = 0, PL_QR = 17408, PL_KT = 34816, PL_VT = 53248, PL_AT = 71680, PL_T1 = 89088, PL_T2 = 98304, PL_VEC = 107520, PL_CW = 108544;
constexpr int P_RM = 272, P_TR = 144, P_AT = 68;
static_assert(PL_AT + 64 * P_AT * 4 <= PL_T1 && PL_CW + 6144 <= RING_BYTES, "prep LDS map");
typedef unsigned v2u __attribute__((ext_vector_type(2)));

__device__ __forceinline__ bf16x8 ldsfrag(const LAS unsigned char* base, int pitch, int row, int k0) { return *(const LAS bf16x8*)(base + row * pitch + k0 * 2); }
__device__ __forceinline__ v4u pack8f(const float (&x)[8]) { v4u o; o.x = pk2c(x[0], x[1]); o.y = pk2c(x[2], x[3]); o.z = pk2c(x[4], x[5]); o.w = pk2c(x[6], x[7]); return o; }
#define MFMA16(a, b, c) __builtin_amdgcn_mfma_f32_16x16x32_bf16((a), (b), (c), 0, 0, 0)

__device__ __forceinline__ void phase_gdn_chunk_prep(Frame& F, unsigned char* ws, const float* conv_w, const float* alog, const float* dtb) {
    const bf16* PROJ = (const bf16*)(ws + WS_PROJ);
    LAS unsigned char* L = F.lds + RING_OFF;
    LAS float* vG = (LAS float*)(L + PL_VEC); LAS float* vEG = vG + 64; LAS float* vEGL = vG + 128; LAS float* vB = vG + 192;
    LAS float* At = (LAS float*)(L + PL_AT);
    LAS float* cwl = (LAS float*)(L + PL_CW);
    const float scale = 0.08838834764831845f;
    int hstaged = -1;
#define CP_LOAD(ci_, X_) do { const int bh_ = (ci_) / GDN_NCH, n_ = (ci_) % GDN_NCH; const size_t m0_ = (size_t)(bh_ / NHEAD) * SEQ + (size_t)n_ * GDN_C; \
        int t2_ = F.tid; asm volatile("" : "+v"(t2_)); const int tok_ = t2_ >> 3, sub_ = t2_ & 7, spos_ = n_ * GDN_C + tok_; \
        const GAS char* pb_ = (const GAS char*)PROJ + ((long long)m0_ - 3) * (NIN * 2) + (PC_GQ + (bh_ % NHEAD) * HD + 16 * sub_) * 2; \
        _Pragma("unroll") for (int mat_ = 0; mat_ < 3; ++mat_) _Pragma("unroll") for (int i_ = 0; i_ < 4; ++i_) { \
            if (spos_ - 3 + i_ >= 0) { const unsigned ro_ = (unsigned)((tok_ + i_) * NIN * 2 + mat_ * GWID * 2); X_[mat_][i_][0] = *(const GAS v4u*)(pb_ + ro_); X_[mat_][i_][1] = *(const GAS v4u*)(pb_ + ro_ + 16); } \
            else { X_[mat_][i_][0] = (v4u){0u, 0u, 0u, 0u}; X_[mat_][i_][1] = (v4u){0u, 0u, 0u, 0u}; } } \
        if (F.wave == 0) { const bf16* pr_ = PROJ + (m0_ + (t2_ & 63)) * NIN + (bh_ % NHEAD); gaw = pr_[PC_GA]; gbw = pr_[PC_GB]; } } while (0)
    const int cper = (GDN_NCHUNKS + F.G - 1) / F.G;
    v4u xr[3][4][2]; bf16 gaw = 0, gbw = 0;
    { const int c0 = blockIdx.x * cper; if (c0 < GDN_NCHUNKS) CP_LOAD(c0, xr); }
    for (int ci = blockIdx.x * cper; ci < GDN_NCHUNKS && ci < (int)(blockIdx.x + 1) * cper; ++ci) {
        int tid = F.tid; asm volatile("" : "+v"(tid));
        const int lane = tid & 63, wv = F.wave, c = lane & 15, g = lane >> 4;
        const int bh = ci / GDN_NCH, n = ci % GDN_NCH, b = bh / NHEAD, h = bh % NHEAD;
        const size_t m0 = (size_t)b * SEQ + (size_t)n * GDN_C;
        if (h != hstaged) {
            __syncthreads();
            for (int i = tid; i < 3 * 4 * 128; i += NWAVES * 64) { const int mat = i / 512, tap = (i / 128) & 3, ch = i & 127; cwl[i] = conv_w[tap * 3 * GWID + mat * GWID + h * HD + ch]; }
            hstaged = h;
            __syncthreads();
        }
        {
            const int tok = tid >> 3, sub = tid & 7, spos = n * GDN_C + tok;
            const GAS char* pback = (const GAS char*)PROJ + ((long long)m0 - 3) * (NIN * 2) + (PC_GQ + h * HD + 16 * sub) * 2;
#pragma unroll
            for (int mat = 0; mat < 3; ++mat) {
                float acc[16];
#pragma unroll
                for (int e = 0; e < 16; ++e) acc[e] = 0.f;
#pragma unroll
                for (int i = 0; i < 4; ++i)
#pragma unroll
                    for (int hf = 0; hf < 2; ++hf) { float x[8]; unpack8(xr[mat][i][hf], x);
                        const LAS float* wp = cwl + (mat * 4 + i) * 128 + 16 * sub + 8 * hf; const f32x4 wa = *(const LAS f32x4*)wp, wb = *(const LAS f32x4*)(wp + 4);
                        acc[8 * hf + 0] += x[0] * wa.x; acc[8 * hf + 1] += x[1] * wa.y; acc[8 * hf + 2] += x[2] * wa.z; acc[8 * hf + 3] += x[3] * wa.w;
                        acc[8 * hf + 4] += x[4] * wb.x; acc[8 * hf + 5] += x[5] * wb.y; acc[8 * hf + 6] += x[6] * wb.z; acc[8 * hf + 7] += x[7] * wb.w; }
                float ss = 0.f;
#pragma unroll
                for (int e = 0; e < 16; ++e) { acc[e] = acc[e] * __builtin_amdgcn_rcpf(1.0f + __expf(-acc[e])); ss += acc[e] * acc[e]; }
                if (mat < 2) { ss += __shfl_xor(ss, 1); ss += __shfl_xor(ss, 2); ss += __shfl_xor(ss, 4);
                    const float r = __builtin_amdgcn_rsqf(ss + EPS);
#pragma unroll
                    for (int e = 0; e < 16; ++e) acc[e] *= r; }
                unsigned pw[8];
#pragma unroll
                for (int e = 0; e < 8; ++e) pw[e] = pk2c(acc[2 * e], acc[2 * e + 1]);
                if (mat < 2) { LAS unsigned char* img = L + (mat == 0 ? PL_QR : PL_KR) + tok * P_RM + sub * 32;
                    *(LAS v4u*)img = (v4u){pw[0], pw[1], pw[2], pw[3]}; *(LAS v4u*)(img + 16) = (v4u){pw[4], pw[5], pw[6], pw[7]}; }
                if (mat >= 1) { LAS unsigned char* timg = L + (mat == 1 ? PL_KT : PL_VT) + (16 * sub) * P_TR + tok * 2;
#pragma unroll
                    for (int e = 0; e < 8; ++e) { *(LAS unsigned short*)(timg + (2 * e) * P_TR) = (unsigned short)(pw[e] & 0xffffu); *(LAS unsigned short*)(timg + (2 * e + 1) * P_TR) = (unsigned short)(pw[e] >> 16); } }
            }
        }
        if (wv == 0) {
            const float ga = bf1(gaw), gb = bf1(gbw);
            const float xx = ga + dtb[h];
            const float sp = xx > 20.0f ? xx : log1pf(expf(xx));
            float x = -expf(alog[h]) * sp;
#pragma unroll
            for (int o = 1; o < 64; o <<= 1) { const float y = __shfl_up(x, o); if (lane >= o) x += y; }
            const float glast = __shfl(x, 63);
            vG[lane] = x; vEG[lane] = __expf(x); vEGL[lane] = __expf(glast - x); vB[lane] = 1.0f / (1.0f + expf(-gb));
            if (lane == 63) ((float*)(ws + WS_GL))[ci] = __expf(x);
        }
        __syncthreads();
        if (ci + 1 < GDN_NCHUNKS && ci + 1 < (int)(blockIdx.x + 1) * cper) CP_LOAD(ci + 1, xr);
        if (wv < 4) {
            const int it = wv;
            bf16x8 fa[4], fb[4][4];
#pragma unroll
            for (int s = 0; s < 4; ++s) fa[s] = ldsfrag(L + PL_KR, P_RM, 16 * it + c, 32 * s + 8 * g);
#pragma unroll
            for (int jt = 0; jt < 4; ++jt)
#pragma unroll
                for (int s = 0; s < 4; ++s) fb[jt][s] = ldsfrag(L + PL_KR, P_RM, 16 * jt + c, 32 * s + 8 * g);
            asm volatile("s_waitcnt lgkmcnt(0)" ::: "memory"); __builtin_amdgcn_sched_barrier(0);
#pragma unroll
            for (int jt = 0; jt < 4; ++jt) {
                f32x4 acc = {0.f, 0.f, 0.f, 0.f};
#pragma unroll
                for (int s = 0; s < 4; ++s) acc = MFMA16(fa[s], fb[jt][s], acc);
                const int j = 16 * jt + c; const float Gj = vG[j];
#pragma unroll
                for (int r = 0; r < 4; ++r) { const int i = 16 * it + 4 * g + r;
                    At[j * P_AT + i] = (i > j) ? vB[i] * acc[r] * __expf(vG[i] - Gj) : 0.0f; }
            }
        } else {
            const int sp = (wv - 4) >> 1, half = (wv - 4) & 1;
            bf16x8 fk[2][4], fq[2][4];
#pragma unroll
            for (int x = 0; x < 2; ++x)
#pragma unroll
                for (int s = 0; s < 4; ++s) { fk[x][s] = ldsfrag(L + PL_KR, P_RM, 16 * (2 * sp + x) + c, 32 * s + 8 * g); fq[x][s] = ldsfrag(L + PL_QR, P_RM, 16 * (2 * half + x) + c, 32 * s + 8 * g); }
            asm volatile("s_waitcnt lgkmcnt(0)" ::: "memory"); __builtin_amdgcn_sched_barrier(0);
#pragma unroll
            for (int ii = 0; ii < 2; ++ii) {
                const int itp = 2 * half + ii; float out[8];
                const int i = 16 * itp + c; const float Gi = vG[i];
#pragma unroll
                for (int jj = 0; jj < 2; ++jj) {
                    const int jt = 2 * sp + jj;
                    f32x4 acc = {0.f, 0.f, 0.f, 0.f};
#pragma unroll
                    for (int s = 0; s < 4; ++s) acc = MFMA16(fk[jj][s], fq[ii][s], acc);
#pragma unroll
                    for (int r = 0; r < 4; ++r) { const int j = 16 * jt + 4 * g + r; out[4 * jj + r] = (i >= j) ? scale * acc[r] * __expf(Gi - vG[j]) : 0.0f; }
                }
                *(GAS v4u*)(ws + WS_CH + (size_t)ci * CH_BYTES + CH_QK + ((itp * 2 + sp) * 64 + lane) * 16) = pack8f(out);
            }
        }
        __syncthreads();
        constexpr int PD = 20;
        LAS float* Drow = (LAS float*)(L + PL_KR); LAS float* Dcol = Drow + 64 * PD;
        if (wv == 0) {
            float col[16];
#pragma unroll
            for (int i = 0; i < 16; ++i) col[i] = (i == c) ? 1.0f : 0.0f;
            const LAS float* Ad = At + (16 * g) * (P_AT + 1);
#pragma unroll
            for (int j = 0; j < 15; ++j) {
                f32x4 a[4];
#pragma unroll
                for (int q = (j + 1) >> 2; q < 4; ++q) a[q] = *(const LAS f32x4*)(Ad + j * P_AT + 4 * q);
                __builtin_amdgcn_sched_barrier(0);
                const float cj = col[j];
#pragma unroll
                for (int i = j + 1; i < 16; ++i) col[i] -= a[i >> 2][i & 3] * cj;
                __builtin_amdgcn_sched_barrier(0);
            }
#pragma unroll
            for (int q = 0; q < 4; ++q) *(LAS f32x4*)(Dcol + lane * PD + 4 * q) = (f32x4){col[4 * q], col[4 * q + 1], col[4 * q + 2], col[4 * q + 3]};
            const float b1 = vB[lane], b2 = b1 * vEG[lane];
#pragma unroll
            for (int i = 0; i < 16; ++i) {
                Drow[(16 * g + i) * PD + c] = col[i];
                *(LAS unsigned short*)(L + PL_T1 + (16 * g + i) * P_TR + lane * 2) = (unsigned short)f2bf(col[i] * b1);
                *(LAS unsigned short*)(L + PL_T2 + (16 * g + i) * P_TR + lane * 2) = (unsigned short)f2bf(col[i] * b2);
            }
        } else {
            for (int f = wv - 1; f < 32; f += 7) {
                float x[8];
                if (f < 16) {
                    const int tt = f >> 2, s = f & 3, tok = 16 * tt + c;
                    const v2u lo = *(const LAS v2u*)(L + PL_QR + tok * P_RM + (32 * s + 4 * g) * 2), hi = *(const LAS v2u*)(L + PL_QR + tok * P_RM + (32 * s + 16 + 4 * g) * 2);
                    const float fs = scale * vEG[tok];
                    x[0] = bf_lo(lo.x) * fs; x[1] = bf_hi(lo.x) * fs; x[2] = bf_lo(lo.y) * fs; x[3] = bf_hi(lo.y) * fs;
                    x[4] = bf_lo(hi.x) * fs; x[5] = bf_hi(hi.x) * fs; x[6] = bf_lo(hi.y) * fs; x[7] = bf_hi(hi.y) * fs;
                    *(GAS v4u*)(ws + WS_CH + (size_t)ci * CH_BYTES + CH_QD + (f * 64 + lane) * 16) = pack8f(x);
                } else {
                    const int ff = f - 16, dt = ff >> 1, sp = ff & 1, dk = 16 * dt + c;
                    const v2u lo = *(const LAS v2u*)(L + PL_KT + dk * P_TR + (32 * sp + 4 * g) * 2), hi = *(const LAS v2u*)(L + PL_KT + dk * P_TR + (32 * sp + 16 + 4 * g) * 2);
                    const f32x4 e0 = *(const LAS f32x4*)(vEGL + 32 * sp + 4 * g), e1 = *(const LAS f32x4*)(vEGL + 32 * sp + 16 + 4 * g);
                    x[0] = bf_lo(lo.x) * e0.x; x[1] = bf_hi(lo.x) * e0.y; x[2] = bf_lo(lo.y) * e0.z; x[3] = bf_hi(lo.y) * e0.w;
                    x[4] = bf_lo(hi.x) * e1.x; x[5] = bf_hi(hi.x) * e1.y; x[6] = bf_lo(hi.y) * e1.z; x[7] = bf_hi(hi.y) * e1.w;
                    *(GAS v4u*)(ws + WS_CH + (size_t)ci * CH_BYTES + CH_KD + (ff * 64 + lane) * 16) = pack8f(x);
                }
            }
        }
        __syncthreads();
#define INV_CHAIN(B) do { \
            f32x4 T_[4]; T_[B] = *(const LAS f32x4*)(Dcol + (16 * (B) + c) * PD + 4 * g); \
            const float b1c = vB[16 * (B) + c], b2c = b1c * vEG[16 * (B) + c]; \
            _Pragma("unroll") for (int a_ = (B) + 1; a_ < 4; ++a_) { \
                f32x4 Y_ = {0.f, 0.f, 0.f, 0.f}; \
                _Pragma("unroll") for (int m_ = (B); m_ < a_; ++m_) \
                    _Pragma("unroll") for (int kk = 0; kk < 4; ++kk) Y_ = __builtin_amdgcn_mfma_f32_16x16x4f32(At[(16 * m_ + 4 * g + kk) * P_AT + 16 * a_ + c], T_[m_][kk], Y_, 0, 0, 0); \
                const f32x4 da_ = *(const LAS f32x4*)(Drow + (16 * a_ + c) * PD + 4 * g); \
                f32x4 Z_ = {0.f, 0.f, 0.f, 0.f}; \
                _Pragma("unroll") for (int kk = 0; kk < 4; ++kk) Z_ = __builtin_amdgcn_mfma_f32_16x16x4f32(da_[kk], Y_[kk], Z_, 0, 0, 0); \
                T_[a_] = -Z_; \
                _Pragma("unroll") for (int r = 0; r < 4; ++r) { \
                    *(LAS unsigned short*)(L + PL_T1 + (16 * a_ + 4 * g + r) * P_TR + (16 * (B) + c) * 2) = (unsigned short)f2bf(T_[a_][r] * b1c); \
                    *(LAS unsigned short*)(L + PL_T2 + (16 * a_ + 4 * g + r) * P_TR + (16 * (B) + c) * 2) = (unsigned short)f2bf(T_[a_][r] * b2c); } } } while (0)
        if (wv == 0) INV_CHAIN(0); else if (wv == 1) INV_CHAIN(1); else if (wv == 2) INV_CHAIN(2);
        else if (wv == 3) {
#pragma unroll
            for (int it = 0; it < 6; ++it) { const int item = lane + 64 * it, img = item / 192, rest = item % 192, blk = rest >> 5, row = (rest & 31) >> 1, hf = rest & 1;
                const int ba = blk < 3 ? 0 : (blk < 5 ? 1 : 2), bb = blk < 3 ? blk + 1 : (blk < 5 ? blk - 1 : 3);
                *(LAS v4u*)(L + (img ? PL_T2 : PL_T1) + (16 * ba + row) * P_TR + 32 * bb + 16 * hf) = (v4u){0u, 0u, 0u, 0u}; }
        }
#undef INV_CHAIN
        __syncthreads();
        float vone = 1.0f; asm volatile("" : "+v"(vone));
        if (wv < 4) {
            const int it = wv;
            bf16x8 ft[2], fv[8][2];
#pragma unroll
            for (int sp = 0; sp < 2; ++sp) ft[sp] = ldsfrag(L + PL_T1, P_TR, 16 * it + c, 32 * sp + 8 * g);
#pragma unroll
            for (int dvt = 0; dvt < 8; ++dvt)
#pragma unroll
                for (int sp = 0; sp < 2; ++sp) fv[dvt][sp] = ldsfrag(L + PL_VT, P_TR, 16 * dvt + c, 32 * sp + 8 * g);
            asm volatile("s_waitcnt lgkmcnt(0)" ::: "memory"); __builtin_amdgcn_sched_barrier(0);
#pragma unroll
            for (int dvt = 0; dvt < 8; ++dvt) {
                f32x4 acc = {0.f, 0.f, 0.f, 0.f};
#pragma unroll
                for (int sp = 0; sp < 2; ++sp) acc = MFMA16(ft[sp], fv[dvt][sp], acc);
                acc = acc * vone;
                v2u o; o.x = pk2c(acc[0], acc[1]); o.y = pk2c(acc[2], acc[3]);
                *(GAS v2u*)(ws + WS_CH + (size_t)ci * CH_BYTES + CH_UF + ((dvt * 4 + it) * 64 + lane) * 8) = o;
            }
        } else {
            const int it = wv - 4;
            bf16x8 ft2[2], fkt[8][2];
#pragma unroll
            for (int sp = 0; sp < 2; ++sp) ft2[sp] = ldsfrag(L + PL_T2, P_TR, 16 * it + c, 32 * sp + 8 * g);
#pragma unroll
            for (int dkt = 0; dkt < 8; ++dkt)
#pragma unroll
                for (int sp = 0; sp < 2; ++sp) fkt[dkt][sp] = ldsfrag(L + PL_KT, P_TR, 16 * dkt + c, 32 * sp + 8 * g);
            asm volatile("s_waitcnt lgkmcnt(0)" ::: "memory"); __builtin_amdgcn_sched_barrier(0);
#pragma unroll
            for (int s = 0; s < 4; ++s) {
                float x[8];
#pragma unroll
                for (int dd = 0; dd < 2; ++dd) {
                    const int dkt = 2 * s + dd;
                    f32x4 acc = {0.f, 0.f, 0.f, 0.f};
#pragma unroll
                    for (int sp = 0; sp < 2; ++sp) acc = MFMA16(fkt[dkt][sp], ft2[sp], acc);
                    x[4 * dd] = acc[0] * vone; x[4 * dd + 1] = acc[1] * vone; x[4 * dd + 2] = acc[2] * vone; x[4 * dd + 3] = acc[3] * vone;
                }
                *(GAS v4u*)(ws + WS_CH + (size_t)ci * CH_BYTES + CH_WF + ((it * 4 + s) * 64 + lane) * 16) = pack8f(x);
            }
        }
        __syncthreads();
    }
}

__device__ __forceinline__ float row16_sum(float v) {
    v += __builtin_bit_cast(float, __builtin_amdgcn_update_dpp(0, __builtin_bit_cast(int, v), 0xB1, 0xF, 0xF, true));
    v += __builtin_bit_cast(float, __builtin_amdgcn_update_dpp(0, __builtin_bit_cast(int, v), 0x4E, 0xF, 0xF, true));
    v += __builtin_bit_cast(float, __builtin_amdgcn_update_dpp(0, __builtin_bit_cast(int, v), 0x141, 0xF, 0xF, true));
    v += __builtin_bit_cast(float, __builtin_amdgcn_update_dpp(0, __builtin_bit_cast(int, v), 0x140, 0xF, 0xF, true));
    return v;
}
#undef CP_LOAD
__device__ __forceinline__ void gdn_scan_task(Frame& F, int bh, int dvh, unsigned char* ws) {
    int lane = F.lane; asm volatile("" : "+v"(lane));
    const int wv = F.wave, c = lane & 15, g = lane >> 4, b = bh / NHEAD, h = bh % NHEAD;
    const bool comp = wv < 4;
    const int dvt = 4 * dvh + (wv & 3);
    LAS unsigned char* L = F.lds + RING_OFF;
    float* GO = (float*)(ws + WS_GO);
    const unsigned char* rec0 = ws + WS_CH + (size_t)bh * GDN_NCH * CH_BYTES;
    const float* GLp = (const float*)(ws + WS_GL) + (size_t)bh * GDN_NCH;
    f32x4 S[8];
#pragma unroll
    for (int i = 0; i < 8; ++i) S[i] = (f32x4){0.f, 0.f, 0.f, 0.f};
#define SCAN_ISSUE(n_, buf_) do { const unsigned char* src_ = rec0 + (size_t)(n_) * CH_BYTES + lane * 16; \
        _Pragma("unroll") for (int i_ = 0; i_ < 14; ++i_) __builtin_amdgcn_global_load_lds((const unsigned*)(src_ + ((wv - 4) + 4 * i_) * 1024), (LAS unsigned*)(L + (buf_) * CH_LDS + ((wv - 4) + 4 * i_) * 1024), 16, 0, 0); } while (0)
#define SCAN_WARM(n_) do { const unsigned char* src_ = rec0 + (size_t)(n_) * CH_BYTES + lane * 16; \
        _Pragma("unroll") for (int i_ = 0; i_ < 28; ++i_) __builtin_amdgcn_global_load_lds((const unsigned*)(src_ + ((wv - 6) + 2 * i_) * 1024), (LAS unsigned*)(L + 2 * CH_LDS + (wv - 6) * 1024), 16, 0, 0); } while (0)
    constexpr int SCAN_PF = 4;
#define SCAN_LOADU(n_, U_) do { const GAS v2u* up_ = (const GAS v2u*)(rec0 + (size_t)(n_) * CH_BYTES + CH_UF) + (dvt * 4) * 64 + lane; \
        _Pragma("unroll") for (int tt_ = 0; tt_ < 4; ++tt_) U_[tt_] = up_[tt_ * 64]; } while (0)
    v2u U[4], Un[4]; float gl = 0.f, gln;
    const bool dmaw = (wv >= 4), warmw = false;
    if (comp) { SCAN_LOADU(0, Un); gln = GLp[0]; } else { gln = 0.f; _Pragma("unroll") for (int tt = 0; tt < 4; ++tt) Un[tt] = (v2u){0u, 0u}; }
    if (dmaw) SCAN_ISSUE(0, 0);
    if (warmw) { for (int w_ = 1; w_ <= SCAN_PF; ++w_) SCAN_WARM(w_); }
#pragma unroll
    for (int tt = 0; tt < 4; ++tt) U[tt] = Un[tt];
    const unsigned olo = (unsigned)(((4 * g) * GWID + c) * 4);
    asm volatile("s_waitcnt vmcnt(0)" ::: "memory"); __builtin_amdgcn_s_barrier(); asm volatile("" ::: "memory");
    for (int n = 0; n < GDN_NCH; ++n) {
#pragma unroll
        for (int tt = 0; tt < 4; ++tt) U[tt] = Un[tt];
        gl = gln;
        if (warmw) { if (n + 1 + SCAN_PF < GDN_NCH) SCAN_WARM(n + 1 + SCAN_PF); }
        if (dmaw && n + 1 < GDN_NCH) SCAN_ISSUE(n + 1, (n + 1) & 1);
        if (comp && n + 1 < GDN_NCH) { SCAN_LOADU(n + 1, Un); gln = GLp[n + 1]; }
        if (comp) {
            const LAS unsigned char* B = L + (n & 1) * CH_LDS + lane * 16;
            bf16x8 FA[16], FB[8];
#define LDF(dst, off) dst = *(const LAS bf16x8*)(B + (off))
#define WAITL(n_) do { asm volatile("s_waitcnt lgkmcnt(" #n_ ")" ::: "memory"); __builtin_amdgcn_sched_barrier(0); } while (0)
#pragma unroll
            for (int i = 0; i < 16; ++i) LDF(FA[i], CH_WF + i * 1024);
#pragma unroll
            for (int i = 0; i < 8; ++i) LDF(FB[i], CH_QD + i * 1024);
            bf16x8 Sb[4];
#pragma unroll
            for (int s = 0; s < 4; ++s) { v4u w; w.x = pk2c(S[2 * s][0], S[2 * s][1]); w.y = pk2c(S[2 * s][2], S[2 * s][3]); w.z = pk2c(S[2 * s + 1][0], S[2 * s + 1][1]); w.w = pk2c(S[2 * s + 1][2], S[2 * s + 1][3]);
                Sb[s] = __builtin_bit_cast(bf16x8, w); }
            WAITL(8);
            f32x4 vn[4];
#pragma unroll
            for (int tt = 0; tt < 4; ++tt) {
                f32x4 acc = {0.f, 0.f, 0.f, 0.f};
#pragma unroll
                for (int s = 0; s < 4; ++s) acc = MFMA16(FA[tt * 4 + s], Sb[s], acc);
                const v2u uu = U[tt];
                vn[tt] = (f32x4){bf_lo(uu.x) - acc[0], bf_hi(uu.x) - acc[1], bf_lo(uu.y) - acc[2], bf_hi(uu.y) - acc[3]};
            }
            __builtin_amdgcn_sched_barrier(0);
#pragma unroll
            for (int i = 0; i < 8; ++i) LDF(FA[i], CH_QD + (8 + i) * 1024);
            WAITL(8);
            f32x4 OO[4];
#pragma unroll
            for (int tt = 0; tt < 2; ++tt) {
                f32x4 acc = {0.f, 0.f, 0.f, 0.f};
#pragma unroll
                for (int s = 0; s < 4; ++s) acc = MFMA16(FB[tt * 4 + s], Sb[s], acc);
                OO[tt] = acc;
            }
            __builtin_amdgcn_sched_barrier(0);
#pragma unroll
            for (int i = 0; i < 8; ++i) LDF(FB[i], CH_QK + i * 1024);
            WAITL(8);
#pragma unroll
            for (int tt = 2; tt < 4; ++tt) {
                f32x4 acc = {0.f, 0.f, 0.f, 0.f};
#pragma unroll
                for (int s = 0; s < 4; ++s) acc = MFMA16(FA[(tt - 2) * 4 + s], Sb[s], acc);
                OO[tt] = acc;
            }
            bf16x8 Vb[2];
#pragma unroll
            for (int sp = 0; sp < 2; ++sp) { v4u w; w.x = pk2c(vn[2 * sp][0], vn[2 * sp][1]); w.y = pk2c(vn[2 * sp][2], vn[2 * sp][3]); w.z = pk2c(vn[2 * sp + 1][0], vn[2 * sp + 1][1]); w.w = pk2c(vn[2 * sp + 1][2], vn[2 * sp + 1][3]);
                Vb[sp] = __builtin_bit_cast(bf16x8, w); }
            __builtin_amdgcn_sched_barrier(0);
#pragma unroll
            for (int i = 0; i < 8; ++i) LDF(FA[8 + i], CH_KD + i * 1024);
            WAITL(8);
            GAS char* gob = (GAS char*)(GO + ((size_t)b * SEQ + (size_t)n * GDN_C) * GWID + h * HD + 16 * dvt);
#pragma unroll
            for (int tt = 0; tt < 4; ++tt) {
                f32x4 acc = OO[tt];
#pragma unroll
                for (int sp = 0; sp < 2; ++sp) acc = MFMA16(FB[tt * 2 + sp], Vb[sp], acc);
#pragma unroll
                for (int r = 0; r < 4; ++r) *(GAS float*)(gob + (size_t)((16 * tt + r) * GWID * 4) + olo) = acc[r];
            }
            __builtin_amdgcn_sched_barrier(0);
#pragma unroll
            for (int i = 0; i < 8; ++i) LDF(FB[i], CH_KD + (8 + i) * 1024);
            WAITL(8);
#pragma unroll
            for (int dkt = 0; dkt < 4; ++dkt) {
                f32x4 acc = S[dkt] * gl;
#pragma unroll
                for (int sp = 0; sp < 2; ++sp) acc = MFMA16(FA[8 + dkt * 2 + sp], Vb[sp], acc);
                S[dkt] = acc;
            }
            WAITL(0);
#pragma unroll
            for (int dkt = 4; dkt < 8; ++dkt) {
                f32x4 acc = S[dkt] * gl;
#pragma unroll
                for (int sp = 0; sp < 2; ++sp) acc = MFMA16(FB[(dkt - 4) * 2 + sp], Vb[sp], acc);
                S[dkt] = acc;
            }
#undef LDF
#undef WAITL
        }
        if (dmaw) asm volatile("s_waitcnt vmcnt(0)" ::: "memory");
        asm volatile("s_waitcnt lgkmcnt(0)" ::: "memory");
        __builtin_amdgcn_s_barrier(); asm volatile("" ::: "memory");
    }
    asm volatile("s_waitcnt vmcnt(0)" ::: "memory");
#undef SCAN_WARM
#undef SCAN_ISSUE
#undef SCAN_LOADU
}
constexpr int CW_QUEUE = 8192;
constexpr float LOG2E = 1.4426950408889634f;
constexpr int AT_KB = 16384, AT_BUF = 32768, AT_NSTAGE = 3;
constexpr int AT_KM = AT_NSTAGE * AT_BUF, AT_MISC = AT_KM + 16384;
static_assert(AT_MISC + 64 <= RING_BYTES, "attention LDS map");

__device__ __forceinline__ v4u gld16(const void* base, unsigned off) { return *(const GAS v4u*)((const GAS char*)base + off); }
__device__ __forceinline__ void gst8(void* base, unsigned off, v2u v) { *(GAS v2u*)((GAS char*)base + off) = v; }
__device__ __forceinline__ bf16x8 frag2(const LAS unsigned char* p0, const LAS unsigned char* p1) {
    const v2u a = *(const LAS v2u*)p0, b = *(const LAS v2u*)p1; v4u w; w.x = a.x; w.y = a.y; w.z = b.x; w.w = b.y; return __builtin_bit_cast(bf16x8, w);
}
__device__ __forceinline__ bf16x8 packP(const f32x4& a, const f32x4& b) { v4u w; w.x = pk2c(a[0], a[1]); w.y = pk2c(a[2], a[3]); w.z = pk2c(b[0], b[1]); w.w = pk2c(b[2], b[3]); return __builtin_bit_cast(bf16x8, w); }
__device__ __forceinline__ float grp_max(float v) {
    { auto r = __builtin_amdgcn_permlane16_swap(__float_as_uint(v), __float_as_uint(v), false, false); v = fmaxf(__uint_as_float(r[0]), __uint_as_float(r[1])); }
    { auto r = __builtin_amdgcn_permlane32_swap(__float_as_uint(v), __float_as_uint(v), false, false); v = fmaxf(__uint_as_float(r[0]), __uint_as_float(r[1])); }
    return v; }
__device__ __forceinline__ float grp_sum(float v) {
    { auto r = __builtin_amdgcn_permlane16_swap(__float_as_uint(v), __float_as_uint(v), false, false); v = __uint_as_float(r[0]) + __uint_as_float(r[1]); }
    { auto r = __builtin_amdgcn_permlane32_swap(__float_as_uint(v), __float_as_uint(v), false, false); v = __uint_as_float(r[0]) + __uint_as_float(r[1]); }
    return v; }

__device__ __forceinline__ void moba_unit(Frame& F, int b, int h, int blk, int qh, unsigned char* ws) {
    const bf16* QN = (const bf16*)(ws + WS_QN); const bf16* KN = (const bf16*)(ws + WS_KN); const bf16* VTG = (const bf16*)(ws + WS_VTG); const float* KMEAN = (const float*)(ws + WS_KMEAN);
    bf16* MIX = (bf16*)(ws + WS_MIX);
    LAS unsigned char* L = F.lds + RING_OFF;
    int tid_ = F.tid; asm volatile("" : "+v"(tid_));
    const int tid = tid_, lane = tid & 63, wv = F.wave, c = lane & 15, g = lane >> 4;
    const int bh = b * NHEAD + h;
    const int qw0 = blk * MOBA_BLK + 128 * qh + 16 * wv;
    const size_t mq0 = (size_t)b * SEQ + qw0;
    { const GAS f32x4* src = (const GAS f32x4*)(KMEAN + (size_t)bh * MOBA_NB * HD); LAS f32x4* dst = (LAS f32x4*)(L + AT_KM);
#pragma unroll
      for (int i = 0; i < 2; ++i) dst[tid + 512 * i] = src[tid + 512 * i]; }
    __syncthreads();
    unsigned selmask;
    {
        float gate[8];
#pragma unroll
        for (int nn = 0; nn < 8; ++nn) gate[nn] = 0.f;
        const bf16* qbase = QN + mq0 * GWID + h * HD; const unsigned qoff = (unsigned)c * (GWID * 2);
        const LAS float* km = (const LAS float*)(L + AT_KM) + g * HD;
        for (int dc = 0; dc < 16; ++dc) {
            const v4u w = gld16(qbase, qoff + 16 * dc);
            const float q0 = bf_lo(w.x), q1 = bf_hi(w.x), q2 = bf_lo(w.y), q3 = bf_hi(w.y), q4 = bf_lo(w.z), q5 = bf_hi(w.z), q6 = bf_lo(w.w), q7 = bf_hi(w.w);
#pragma unroll
            for (int nn = 0; nn < 8; ++nn) {
                const f32x4 ka = *(const LAS f32x4*)(km + nn * 4 * HD + 8 * dc), kb = *(const LAS f32x4*)(km + nn * 4 * HD + 8 * dc + 4);
                gate[nn] += q0 * ka.x + q1 * ka.y + q2 * ka.z + q3 * ka.w + q4 * kb.x + q5 * kb.y + q6 * kb.z + q7 * kb.w;
            }
        }
        float tv[3]; int ti[3];
#pragma unroll
        for (int t = 0; t < 3; ++t) {
            float bv = -INFINITY; int bi = -1;
#pragma unroll
            for (int nn = 0; nn < 8; ++nn) { const int n = 4 * nn + g; const float v = (n < blk) ? gate[nn] : -INFINITY; if (v > bv) { bv = v; bi = n; } }
#pragma unroll
            for (int nn = 0; nn < 8; ++nn) if (4 * nn + g == bi) gate[nn] = -INFINITY;
            tv[t] = bv; ti[t] = bi;
        }
#pragma unroll
        for (int stage = 0; stage < 2; ++stage) {
            const int xm = stage == 0 ? 16 : 32;
            float cv[6]; int cidx[6];
#pragma unroll
            for (int t = 0; t < 3; ++t) { cv[t] = tv[t]; cidx[t] = ti[t]; cv[3 + t] = __shfl_xor(tv[t], xm); cidx[3 + t] = __shfl_xor(ti[t], xm); }
#pragma unroll
            for (int t = 0; t < 3; ++t) {
                float bv = -INFINITY; int bi = -1, bs = -1;
#pragma unroll
                for (int s = 0; s < 6; ++s) { const bool better = (cv[s] > bv) || (cv[s] == bv && cv[s] > -INFINITY && cidx[s] < bi); if (better) { bv = cv[s]; bi = cidx[s]; bs = s; } }
#pragma unroll
                for (int s = 0; s < 6; ++s) if (s == bs) cv[s] = -INFINITY;
                tv[t] = bv; ti[t] = bi;
            }
        }
        unsigned msk = 0u;
#pragma unroll
        for (int t = 0; t < 3; ++t) if (ti[t] >= 0) msk |= (1u << ti[t]);
        selmask = msk;
    }
    const unsigned qmask = selmask;
    unsigned wor = selmask;
#pragma unroll
    for (int o = 1; o < 16; o <<= 1) wor |= (unsigned)__shfl_xor((int)wor, o);
    wor = (unsigned)__builtin_amdgcn_readfirstlane((int)wor);
    bf16x8 Qf[4];
#pragma unroll
    for (int ks = 0; ks < 4; ++ks) Qf[ks] = __builtin_bit_cast(bf16x8, gld16(QN + mq0 * GWID + h * HD, (unsigned)(c * (GWID * 2) + (32 * ks + 8 * g) * 2)));
    asm volatile("" : "+v"(Qf[0]), "+v"(Qf[1]), "+v"(Qf[2]), "+v"(Qf[3]));
    f32x4 O[8];
#pragma unroll
    for (int dt = 0; dt < 8; ++dt) O[dt] = (f32x4){0.f, 0.f, 0.f, 0.f};
    float lrow = 0.f;
    const float sc2 = 0.08838834764831845f * LOG2E;
    constexpr float MOBA_SHIFT2 = 8.0f * LOG2E;
#define AT_KEYBASE(t) (((t) < 4) ? (blk * MOBA_BLK + 64 * (t)) : (64 * ((t) - 4)))
    const int nown = (qh == 0) ? 2 : 4, NTE = nown + 4 * blk;
#define AT_TILE(i) (((i) < nown) ? (i) : (4 + (i) - nown))
    const unsigned ksrc0 = (unsigned)(((4 * wv + (lane >> 4)) * GWID) * 2 + (((lane & 15) ^ ((4 * wv + (lane >> 4)) & 15)) * 16));
    const unsigned ksrc1 = (unsigned)(((4 * (wv + 8) + (lane >> 4)) * GWID) * 2 + (((lane & 15) ^ ((4 * (wv + 8) + (lane >> 4)) & 15)) * 16));
    const unsigned vsrc0 = (unsigned)(((8 * wv + (lane >> 3)) * SEQ) * 2 + (((lane & 7) ^ (((8 * wv + (lane >> 3)) >> 1) & 7)) * 16));
    const unsigned vsrc1 = (unsigned)(((8 * (wv + 8) + (lane >> 3)) * SEQ) * 2 + (((lane & 7) ^ (((8 * (wv + 8) + (lane >> 3)) >> 1) & 7)) * 16));
#define AT_ISSUE(i, st) do { const int kb_ = AT_KEYBASE(AT_TILE(i)); const GAS char* kbase_ = (const GAS char*)(KN + ((size_t)b * SEQ + kb_) * GWID + h * HD); const GAS char* vbase_ = (const GAS char*)(VTG + (size_t)bh * HD * SEQ + kb_); \
        LAS unsigned char* B_ = L + (st) * AT_BUF; \
        __builtin_amdgcn_global_load_lds((const unsigned*)(kbase_ + ksrc0), (LAS unsigned*)(B_ + wv * 1024), 16, 0, 0); \
        __builtin_amdgcn_global_load_lds((const unsigned*)(kbase_ + ksrc1), (LAS unsigned*)(B_ + (wv + 8) * 1024), 16, 0, 0); \
        __builtin_amdgcn_global_load_lds((const unsigned*)(vbase_ + vsrc0), (LAS unsigned*)(B_ + AT_KB + wv * 1024), 16, 0, 0); \
        __builtin_amdgcn_global_load_lds((const unsigned*)(vbase_ + vsrc1), (LAS unsigned*)(B_ + AT_KB + (wv + 8) * 1024), 16, 0, 0); } while (0)
    const int vsw = (c >> 1) & 7;
    __syncthreads();
    AT_ISSUE(0, 0); if (NTE > 1) AT_ISSUE(1, 1);
    for (int i = 0; i < NTE; ++i) {
        if (i + 1 < NTE) asm volatile("s_waitcnt vmcnt(4)" ::: "memory"); else asm volatile("s_waitcnt vmcnt(0)" ::: "memory");
        __builtin_amdgcn_s_barrier(); asm volatile("" ::: "memory");
        if (i + 2 < NTE) AT_ISSUE(i + 2, (i + 2) % AT_NSTAGE);
        const int t = AT_TILE(i);
        const int kb = AT_KEYBASE(t);
        const int nb = kb >> 8;
        const bool own = (t < 4);
        const bool act = own ? (kb <= qw0 + 15) : (((wor >> nb) & 1u) != 0u);
        if (act) {
            const LAS unsigned char* KB = L + (i % AT_NSTAGE) * AT_BUF; const LAS unsigned char* VB = KB + AT_KB;
            f32x4 S[4];
            bf16x8 Fr[16];
            { const LAS unsigned char* kp = KB + c * 256;
#pragma unroll
              for (int kk = 0; kk < 4; ++kk)
#pragma unroll
                for (int ks = 0; ks < 4; ++ks) Fr[kk * 4 + ks] = *(const LAS bf16x8*)(kp + kk * 4096 + (((4 * ks + g) ^ c) * 16)); }
            asm volatile("s_waitcnt lgkmcnt(0)" ::: "memory"); __builtin_amdgcn_sched_barrier(0);
#pragma unroll
            for (int kk = 0; kk < 4; ++kk) { f32x4 a0 = {0.f, 0.f, 0.f, 0.f};
#pragma unroll
                for (int ks = 0; ks < 4; ++ks) a0 = MFMA16(Fr[kk * 4 + ks], Qf[ks], a0);
                S[kk] = a0; }
            { const LAS unsigned char* vp = VB + c * 128 + 8 * (g & 1);
#pragma unroll
              for (int dt = 0; dt < 8; ++dt) {
                  const LAS unsigned char* vr = vp + dt * 2048;
                  Fr[2 * dt]     = frag2(vr + ((((g >> 1)) ^ vsw) * 16),     vr + ((((g >> 1) + 2) ^ vsw) * 16));
                  Fr[2 * dt + 1] = frag2(vr + (((4 + (g >> 1)) ^ vsw) * 16), vr + (((6 + (g >> 1)) ^ vsw) * 16)); } }
            float ps = 0.f;
            if (own) { const int qpos = qw0 + c;
#pragma unroll
                for (int kk = 0; kk < 4; ++kk)
#pragma unroll
                    for (int r = 0; r < 4; ++r) { const float p = __builtin_amdgcn_exp2f(S[kk][r] * sc2 - MOBA_SHIFT2); S[kk][r] = (kb + 16 * kk + 4 * g + r > qpos) ? 0.f : p; ps += S[kk][r]; }
            } else {
                const bool sel = ((qmask >> nb) & 1u) != 0u;
#pragma unroll
                for (int kk = 0; kk < 4; ++kk)
#pragma unroll
                    for (int r = 0; r < 4; ++r) { const float p = __builtin_amdgcn_exp2f(S[kk][r] * sc2 - MOBA_SHIFT2); S[kk][r] = sel ? p : 0.f; ps += S[kk][r]; }
            }
            lrow += ps;
            const bf16x8 P0 = packP(S[0], S[1]), P1 = packP(S[2], S[3]);
            asm volatile("s_waitcnt lgkmcnt(0)" ::: "memory"); __builtin_amdgcn_sched_barrier(0);
#pragma unroll
            for (int dt = 0; dt < 8; ++dt) { O[dt] = MFMA16(Fr[2 * dt], P0, O[dt]); O[dt] = MFMA16(Fr[2 * dt + 1], P1, O[dt]); }
        }
    }
    asm volatile("s_waitcnt lgkmcnt(0)" ::: "memory");
#undef AT_TILE
#undef AT_ISSUE
#undef AT_KEYBASE
    {
        const float inv = 1.0f / grp_sum(lrow);
        bf16* obase = MIX + mq0 * D + MC_A + h * HD; const unsigned ooff = (unsigned)((c * D + 4 * g) * 2);
#pragma unroll
        for (int dt = 0; dt < 8; ++dt) { v2u o; o.x = pk2c(O[dt][0] * inv, O[dt][1] * inv); o.y = pk2c(O[dt][2] * inv, O[dt][3] * inv); gst8(obase, ooff + 32 * dt, o); }
    }
}

constexpr int SW_KP = 144, SW_VP = 528;
constexpr int SW_KB = 256 * SW_KP;
static_assert(SW_KB + 64 * SW_VP <= AT_KM, "SWA LDS map");
__device__ __forceinline__ void swa_unit(Frame& F, int b, int kvh, int nq, const float* sinks, unsigned char* ws) {
    const bf16* SQN = (const bf16*)(ws + WS_SQN); const bf16* SKN = (const bf16*)(ws + WS_SKN); const bf16* SVT = (const bf16*)(ws + WS_SVT); bf16* MIX = (bf16*)(ws + WS_MIX);
    LAS unsigned char* L = F.lds + RING_OFF;
    int tid_ = F.tid; asm volatile("" : "+v"(tid_));
    const int tid = tid_, lane = tid & 63, wv = F.wave, c = lane & 15, g = lane >> 4;
    const int hq = kvh * 8 + wv;
    const int k0 = nq * SWA_W - SWA_W;
#pragma unroll
    for (int i = 0; i < 4; ++i) {
        const int p = tid + 512 * i;
        { const int row = p >> 3, ch = p & 7; const int kp = k0 + row; v4u w = {0u, 0u, 0u, 0u};
          if (kp >= 0) w = *(const GAS v4u*)(SKN + ((size_t)b * SEQ + kp) * 128 + kvh * 64 + 8 * ch);
          *(LAS v4u*)(L + row * SW_KP + ch * 16) = w; }
        { const int row = p >> 5, ch = p & 31; const int kp = k0 + 8 * ch; v4u w = {0u, 0u, 0u, 0u};
          if (kp >= 0) w = *(const GAS v4u*)(SVT + ((size_t)(b * 2 + kvh) * 64 + row) * SEQ + kp);
          *(LAS v4u*)(L + SW_KB + row * SW_VP + ch * 16) = w; }
    }
    __syncthreads();
    const float sink = sinks[hq];
    const float sc2 = 0.125f * LOG2E;
    for (int qt = 0; qt < 8; ++qt) {
        const int qrel = 16 * qt + c;
        const size_t mqb = (size_t)b * SEQ + nq * SWA_W;
        bf16x8 Qf[2];
#pragma unroll
        for (int ks = 0; ks < 2; ++ks) Qf[ks] = __builtin_bit_cast(bf16x8, gld16(SQN + mqb * GWID + hq * 64, (unsigned)(qrel * (GWID * 2) + (32 * ks + 8 * g) * 2)));
        const int kk0 = qt & ~1;
        f32x4 S[10];
        float tmax = -INFINITY;
#pragma unroll
        for (int j = 0; j < 10; ++j) {
            f32x4 acc = {0.f, 0.f, 0.f, 0.f};
#pragma unroll
            for (int ks = 0; ks < 2; ++ks) acc = MFMA16(*(const LAS bf16x8*)(L + (16 * (kk0 + j) + c) * SW_KP + (32 * ks + 8 * g) * 2), Qf[ks], acc);
#pragma unroll
            for (int r = 0; r < 4; ++r) { const int krow = 16 * (kk0 + j) + 4 * g + r;
                const int dlt = krow - 128 - qrel;
                const bool ok = (dlt <= 0) && (dlt > -SWA_W) && (k0 + krow >= 0);
                acc[r] = ok ? acc[r] : -INFINITY; tmax = fmaxf(tmax, acc[r]); }
            S[j] = acc;
        }
        tmax = grp_max(tmax);
        const float mz = fmaxf(tmax * 0.125f, sink);
        const float mb = mz * LOG2E; float ps = 0.f;
#pragma unroll
        for (int j = 0; j < 10; ++j)
#pragma unroll
            for (int r = 0; r < 4; ++r) { const float p = __builtin_amdgcn_exp2f(S[j][r] * sc2 - mb); S[j][r] = p; ps += p; }
        const float lsum = grp_sum(ps) + __builtin_amdgcn_exp2f((sink - mz) * LOG2E);
        f32x4 O[4];
#pragma unroll
        for (int dt = 0; dt < 4; ++dt) O[dt] = (f32x4){0.f, 0.f, 0.f, 0.f};
#pragma unroll
        for (int s2 = 0; s2 < 5; ++s2) {
            const bf16x8 Pb = packP(S[2 * s2], S[2 * s2 + 1]);
#pragma unroll
            for (int dt = 0; dt < 4; ++dt) {
                const LAS unsigned char* vrow = L + SW_KB + (16 * dt + c) * SW_VP + (16 * (kk0 + 2 * s2) + 4 * g) * 2;
                O[dt] = MFMA16(frag2(vrow, vrow + 32), Pb, O[dt]);
            }
        }
        const float inv = 1.0f / lsum;
        bf16* obase = MIX + mqb * D + MC_D + hq * 64; const unsigned ooff = (unsigned)((qrel * D + 4 * g) * 2);
#pragma unroll
        for (int dt = 0; dt < 4; ++dt) { v2u o; o.x = pk2c(O[dt][0] * inv, O[dt][1] * inv); o.y = pk2c(O[dt][2] * inv, O[dt][3] * inv); gst8(obase, ooff + 32 * dt, o); }
    }
}
constexpr size_t WS_SELM = 1462 * MiB, WS_LIST = 1464 * MiB, WS_PARTL = 1472 * MiB, WS_PARTO = 1475 * MiB, WS_END5 = 1603 * MiB;
static_assert(WS_LIST + (size_t)BATCH * NHEAD * MOBA_NB * SEQ * 2 <= WS_PARTL && WS_PARTL + (size_t)BATCH * NHEAD * SEQ * 4 * 4 <= WS_PARTO && WS_PARTO + (size_t)BATCH * NHEAD * SEQ * 4 * HD * 2 <= WS_END5, "moba2 ws map");
constexpr int CW_CNT = 32768, CW_GATE = 40960;
constexpr int N_LISTS = BATCH * NHEAD * MOBA_NB;
constexpr float MOBA_SHIFT2 = 8.0f * LOG2E;
constexpr int AT_PREF = AT_MISC + 64;
static_assert(AT_PREF + 2048 + 64 <= RING_BYTES, "moba2 LDS map");

__device__ __forceinline__ void moba_gate_unit(Frame& F, int b, int h, int blk, int qh, int layer, unsigned char* ws, bool stage) {
    const bf16* QN = (const bf16*)(ws + WS_QN); const float* KMEAN = (const float*)(ws + WS_KMEAN);
    unsigned* SELM = (unsigned*)(ws + WS_SELM); unsigned short* LIST = (unsigned short*)(ws + WS_LIST);
    LAS unsigned char* L = F.lds + RING_OFF;
    int tid_ = F.tid; asm volatile("" : "+v"(tid_));
    const int tid = tid_, lane = tid & 63, wv = F.wave, c = lane & 15, g = lane >> 4;
    const int bh = b * NHEAD + h;
    const int qw0 = blk * MOBA_BLK + 128 * qh + 16 * wv;
    const size_t mq0 = (size_t)b * SEQ + qw0;
    constexpr int KMP = HD + 4;
    if (stage) {
        __syncthreads();
        const GAS f32x4* src = (const GAS f32x4*)(KMEAN + (size_t)bh * MOBA_NB * HD);
#pragma unroll
        for (int i = 0; i < 2; ++i) { const int idx = tid + 512 * i; *(LAS f32x4*)((LAS float*)L + (idx >> 5) * KMP + 4 * (idx & 31)) = src[idx]; }
        __syncthreads();
    }
    unsigned selmask;
    {
        float gate[8];
        const bf16* qbase = QN + mq0 * GWID + h * HD; const unsigned qoff = (unsigned)c * (GWID * 2) + 64u * (unsigned)g;
        v4u qw[4];
#pragma unroll
        for (int i = 0; i < 4; ++i) qw[i] = gld16(qbase, qoff + 16 * i);
        const LAS float* kmA = (const LAS float*)L + c * KMP + 32 * g;
        f32x4 ka[8], kb[8];
#pragma unroll
        for (int i = 0; i < 8; ++i) { ka[i] = *(const LAS f32x4*)(kmA + 4 * i); kb[i] = *(const LAS f32x4*)(kmA + 16 * KMP + 4 * i); }
        f32x4 accA = {0.f, 0.f, 0.f, 0.f}, accB = {0.f, 0.f, 0.f, 0.f};
#pragma unroll
        for (int kk = 0; kk < 32; ++kk) {
            const unsigned wd = qw[kk >> 3][(kk >> 1) & 3];
            const float q = (kk & 1) ? bf_hi(wd) : bf_lo(wd);
            accA = __builtin_amdgcn_mfma_f32_16x16x4f32(ka[kk >> 2][kk & 3], q, accA, 0, 0, 0);
            accB = __builtin_amdgcn_mfma_f32_16x16x4f32(kb[kk >> 2][kk & 3], q, accB, 0, 0, 0);
        }
#pragma unroll
        for (int r = 0; r < 4; ++r) { gate[r] = accA[r]; gate[4 + r] = accB[r]; }
#define GATE_BLK(nn) (((nn) < 4) ? (4 * g + (nn)) : (16 + 4 * g + (nn) - 4))
        float tv[3]; int ti[3];
#pragma unroll
        for (int t = 0; t < 3; ++t) {
            float bv = -INFINITY; int bi = -1;
#pragma unroll
            for (int nn = 0; nn < 8; ++nn) { const int n = GATE_BLK(nn); const float v = (n < blk) ? gate[nn] : -INFINITY; if (v > bv) { bv = v; bi = n; } }
#pragma unroll
            for (int nn = 0; nn < 8; ++nn) if (GATE_BLK(nn) == bi) gate[nn] = -INFINITY;
            tv[t] = bv; ti[t] = bi;
        }
#pragma unroll
        for (int stage = 0; stage < 2; ++stage) {
            const int xm = stage == 0 ? 16 : 32;
            float cv[6]; int cidx[6];
#pragma unroll
            for (int t = 0; t < 3; ++t) { cv[t] = tv[t]; cidx[t] = ti[t]; cv[3 + t] = __shfl_xor(tv[t], xm); cidx[3 + t] = __shfl_xor(ti[t], xm); }
#pragma unroll
            for (int t = 0; t < 3; ++t) {
                float bv = -INFINITY; int bi = -1, bs = -1;
#pragma unroll
                for (int s = 0; s < 6; ++s) { const bool better = (cv[s] > bv) || (cv[s] == bv && cv[s] > -INFINITY && cidx[s] < bi); if (better) { bv = cv[s]; bi = cidx[s]; bs = s; } }
#pragma unroll
                for (int s = 0; s < 6; ++s) if (s == bs) cv[s] = -INFINITY;
                tv[t] = bv; ti[t] = bi;
            }
        }
        unsigned msk = 0u;
#pragma unroll
        for (int t = 0; t < 3; ++t) if (ti[t] >= 0) msk |= (1u << ti[t]);
        selmask = msk;
    }
    const bool owner = (g == 0);
    if (owner) SELM[(size_t)bh * SEQ + qw0 + c] = selmask;
    unsigned mycnt = 0u;
#pragma unroll
    for (int n = 0; n < 32; ++n) { const unsigned long long bal = __ballot(owner && ((selmask >> n) & 1u)); const unsigned cn = (unsigned)__builtin_popcountll(bal); if (lane == n) mycnt = cn; }
    unsigned mybase = 0u;
    if (lane < 32 && mycnt > 0u) mybase = __hip_atomic_fetch_add(F.ctl + CW_CNT + layer * N_LISTS + bh * MOBA_NB + lane, mycnt, __ATOMIC_RELAXED, __HIP_MEMORY_SCOPE_AGENT);
#pragma unroll
    for (int n = 0; n < 32; ++n) {
        const bool hit = owner && ((selmask >> n) & 1u);
        const unsigned long long bal = __ballot(hit);
        if (bal != 0ull) {
            const unsigned base = (unsigned)__builtin_amdgcn_readlane((int)mybase, n);
            if (hit) { const unsigned pos = base + (unsigned)__builtin_popcountll(bal & ((1ull << lane) - 1ull));
                LIST[((size_t)bh * MOBA_NB + n) * SEQ + pos] = (unsigned short)(qw0 + c); }
        }
    }
}

struct MobaRing {
    unsigned ksrc0, ksrc1, vsrc0, vsrc1; int vsw;
    __device__ __forceinline__ void init(int lane, int wv, int c) {
        ksrc0 = (unsigned)(((4 * wv + (lane >> 4)) * GWID) * 2 + (((lane & 15) ^ ((4 * wv + (lane >> 4)) & 15)) * 16));
        ksrc1 = (unsigned)(((4 * (wv + 8) + (lane >> 4)) * GWID) * 2 + (((lane & 15) ^ ((4 * (wv + 8) + (lane >> 4)) & 15)) * 16));
        vsrc0 = (unsigned)(((8 * wv + (lane >> 3)) * SEQ) * 2 + (((lane & 7) ^ (((8 * wv + (lane >> 3)) >> 1) & 7)) * 16));
        vsrc1 = (unsigned)(((8 * (wv + 8) + (lane >> 3)) * SEQ) * 2 + (((lane & 7) ^ (((8 * (wv + 8) + (lane >> 3)) >> 1) & 7)) * 16));
        vsw = (c >> 1) & 7;
    }
};
#define MR_ISSUE(R, kbase_, vbase_, B_, wv) do { \
        __builtin_amdgcn_global_load_lds((const unsigned*)((const GAS char*)(kbase_) + (R).ksrc0), (LAS unsigned*)((B_) + (wv) * 1024), 16, 0, 0); \
        __builtin_amdgcn_global_load_lds((const unsigned*)((const GAS char*)(kbase_) + (R).ksrc1), (LAS unsigned*)((B_) + ((wv) + 8) * 1024), 16, 0, 0); \
        __builtin_amdgcn_global_load_lds((const unsigned*)((const GAS char*)(vbase_) + (R).vsrc0), (LAS unsigned*)((B_) + AT_KB + (wv) * 1024), 16, 0, 0); \
        __builtin_amdgcn_global_load_lds((const unsigned*)((const GAS char*)(vbase_) + (R).vsrc1), (LAS unsigned*)((B_) + AT_KB + ((wv) + 8) * 1024), 16, 0, 0); } while (0)
template <int MODE>
__device__ __forceinline__ void moba_tile(const LAS unsigned char* KB, const bf16x8 (&Qf)[4], f32x4 (&O)[8], float& lrow, int c, int g, int vsw, int kb, int qpos) {
    const LAS unsigned char* VB = KB + AT_KB;
    const float sc2 = 0.08838834764831845f * LOG2E;
    f32x4 S[4];
    bf16x8 Fr[16];
    { const LAS unsigned char* kp = KB + c * 256;
#pragma unroll
      for (int kk = 0; kk < 4; ++kk)
#pragma unroll
        for (int ks = 0; ks < 4; ++ks) Fr[kk * 4 + ks] = *(const LAS bf16x8*)(kp + kk * 4096 + (((4 * ks + g) ^ c) * 16)); }
    asm volatile("s_waitcnt lgkmcnt(0)" ::: "memory"); __builtin_amdgcn_sched_barrier(0);
#pragma unroll
    for (int kk = 0; kk < 4; ++kk) { f32x4 a0 = {0.f, 0.f, 0.f, 0.f};
#pragma unroll
        for (int ks = 0; ks < 4; ++ks) a0 = MFMA16(Fr[kk * 4 + ks], Qf[ks], a0);
        S[kk] = a0; }
    { const LAS unsigned char* vp = VB + c * 128 + 8 * (g & 1);
#pragma unroll
      for (int dt = 0; dt < 8; ++dt) {
          const LAS unsigned char* vr = vp + dt * 2048;
          Fr[2 * dt]     = frag2(vr + ((((g >> 1)) ^ vsw) * 16),     vr + ((((g >> 1) + 2) ^ vsw) * 16));
          Fr[2 * dt + 1] = frag2(vr + (((4 + (g >> 1)) ^ vsw) * 16), vr + (((6 + (g >> 1)) ^ vsw) * 16)); } }
    float ps = 0.f;
#pragma unroll
    for (int kk = 0; kk < 4; ++kk)
#pragma unroll
        for (int r = 0; r < 4; ++r) { float p = __builtin_amdgcn_exp2f(S[kk][r] * sc2 - MOBA_SHIFT2);
            if (MODE == 1) p = (kb + 16 * kk + 4 * g + r > qpos) ? 0.f : p;
            S[kk][r] = p; ps += p; }
    lrow += ps;
    const bf16x8 P0 = packP(S[0], S[1]), P1 = packP(S[2], S[3]);
    asm volatile("s_waitcnt lgkmcnt(0)" ::: "memory"); __builtin_amdgcn_sched_barrier(0);
#pragma unroll
    for (int dt = 0; dt < 8; ++dt) { O[dt] = MFMA16(Fr[2 * dt], P0, O[dt]); O[dt] = MFMA16(Fr[2 * dt + 1], P1, O[dt]); }
}

__device__ __forceinline__ void moba_gather_unit(Frame& F, int li, int j, int cnt, unsigned char* ws) {
    const bf16* QN = (const bf16*)(ws + WS_QN); const bf16* KN = (const bf16*)(ws + WS_KN); const bf16* VTG = (const bf16*)(ws + WS_VTG);
    const unsigned* SELM = (const unsigned*)(ws + WS_SELM); const unsigned short* LIST = (const unsigned short*)(ws + WS_LIST);
    float* PARTL = (float*)(ws + WS_PARTL); bf16* PARTO = (bf16*)(ws + WS_PARTO);
    LAS unsigned char* L = F.lds + RING_OFF;
    int tid_ = F.tid; asm volatile("" : "+v"(tid_));
    const int tid = tid_, lane = tid & 63, wv = F.wave, c = lane & 15, g = lane >> 4;
    const int bh = li / MOBA_NB, n = li % MOBA_NB, b = bh / NHEAD, h = bh % NHEAD;
    MobaRing R; R.init(lane, wv, c);
    const bf16* kblk = KN + ((size_t)b * SEQ + (size_t)n * MOBA_BLK) * GWID + h * HD; const bf16* vblk = VTG + (size_t)bh * HD * SEQ + (size_t)n * MOBA_BLK;
    MR_ISSUE(R, kblk, vblk, L, wv); MR_ISSUE(R, kblk + 64 * GWID, vblk + 64, L + AT_BUF, wv);
    const int e = 128 * j + 16 * wv + c;
    const bool valid = e < cnt;
    const int q = (int)LIST[(size_t)li * SEQ + (valid ? e : 0)];
    const unsigned msk = SELM[(size_t)bh * SEQ + q];
    const int slot = __builtin_popcount(msk & ((1u << n) - 1u));
    bf16x8 Qf[4];
    { const bf16* qb = QN + ((size_t)b * SEQ) * GWID + h * HD;
#pragma unroll
      for (int ks = 0; ks < 4; ++ks) Qf[ks] = __builtin_bit_cast(bf16x8, gld16(qb, (unsigned)(q * (GWID * 2) + (32 * ks + 8 * g) * 2))); }
    asm volatile("" : "+v"(Qf[0]), "+v"(Qf[1]), "+v"(Qf[2]), "+v"(Qf[3]));
    f32x4 O[8];
#pragma unroll
    for (int dt = 0; dt < 8; ++dt) O[dt] = (f32x4){0.f, 0.f, 0.f, 0.f};
    float lrow = 0.f;
#pragma unroll
    for (int i = 0; i < 4; ++i) {
        if (i + 1 < 4) asm volatile("s_waitcnt vmcnt(4)" ::: "memory"); else asm volatile("s_waitcnt vmcnt(0)" ::: "memory");
        __builtin_amdgcn_s_barrier(); asm volatile("" ::: "memory");
        if (i + 2 < 4) MR_ISSUE(R, kblk + (i + 2) * 64 * GWID, vblk + (i + 2) * 64, L + ((i + 2) % AT_NSTAGE) * AT_BUF, wv);
        moba_tile<0>(L + (i % AT_NSTAGE) * AT_BUF, Qf, O, lrow, c, g, R.vsw, 0, 0);
    }
    const float lsum = grp_sum(lrow);
    if (valid) {
        const size_t pi = ((size_t)bh * SEQ + q) * 4 + slot;
        if (g == 0) PARTL[pi] = lsum;
        GAS char* ob = (GAS char*)(PARTO + pi * HD) + 8 * g;
#pragma unroll
        for (int dt = 0; dt < 8; ++dt) { v2u o; o.x = pk2c(O[dt][0], O[dt][1]); o.y = pk2c(O[dt][2], O[dt][3]); *(GAS v2u*)(ob + 32 * dt) = o; }
    }
}

__device__ __forceinline__ void moba_own_unit(Frame& F, int b, int h, int blk, int qh, unsigned char* ws) {
    const bf16* QN = (const bf16*)(ws + WS_QN); const bf16* KN = (const bf16*)(ws + WS_KN); const bf16* VTG = (const bf16*)(ws + WS_VTG);
    float* PARTL = (float*)(ws + WS_PARTL); bf16* PARTO = (bf16*)(ws + WS_PARTO);
    LAS unsigned char* L = F.lds + RING_OFF;
    int tid_ = F.tid; asm volatile("" : "+v"(tid_));
    const int tid = tid_, lane = tid & 63, wv = F.wave, c = lane & 15, g = lane >> 4;
    const int bh = b * NHEAD + h;
    const int qw0 = blk * MOBA_BLK + 128 * qh + 16 * wv, qpos = qw0 + c;
    const size_t mq0 = (size_t)b * SEQ + qw0;
    MobaRing R; R.init(lane, wv, c);
    const int nown = (qh == 0) ? 2 : 4;
    const bf16* kblk = KN + ((size_t)b * SEQ + (size_t)blk * MOBA_BLK) * GWID + h * HD; const bf16* vblk = VTG + (size_t)bh * HD * SEQ + (size_t)blk * MOBA_BLK;
    MR_ISSUE(R, kblk, vblk, L, wv); MR_ISSUE(R, kblk + 64 * GWID, vblk + 64, L + AT_BUF, wv);
    bf16x8 Qf[4];
#pragma unroll
    for (int ks = 0; ks < 4; ++ks) Qf[ks] = __builtin_bit_cast(bf16x8, gld16(QN + mq0 * GWID + h * HD, (unsigned)(c * (GWID * 2) + (32 * ks + 8 * g) * 2)));
    asm volatile("" : "+v"(Qf[0]), "+v"(Qf[1]), "+v"(Qf[2]), "+v"(Qf[3]));
    f32x4 O[8];
#pragma unroll
    for (int dt = 0; dt < 8; ++dt) O[dt] = (f32x4){0.f, 0.f, 0.f, 0.f};
    float lrow = 0.f;
    for (int i = 0; i < nown; ++i) {
        if (i + 1 < nown) asm volatile("s_waitcnt vmcnt(4)" ::: "memory"); else asm volatile("s_waitcnt vmcnt(0)" ::: "memory");
        __builtin_amdgcn_s_barrier(); asm volatile("" ::: "memory");
        if (i + 2 < nown) MR_ISSUE(R, kblk + (i + 2) * 64 * GWID, vblk + (i + 2) * 64, L + ((i + 2) % AT_NSTAGE) * AT_BUF, wv);
        const int kb = blk * MOBA_BLK + 64 * i;
        if (kb <= qw0 + 15) moba_tile<1>(L + (i % AT_NSTAGE) * AT_BUF, Qf, O, lrow, c, g, R.vsw, kb, qpos);
    }
    const float lsum = grp_sum(lrow);
    const size_t pi = ((size_t)bh * SEQ + qpos) * 4 + 3;
    if (g == 0) PARTL[pi] = lsum;
    GAS char* ob = (GAS char*)(PARTO + pi * HD) + 8 * g;
#pragma unroll
    for (int dt = 0; dt < 8; ++dt) { v2u o; o.x = pk2c(O[dt][0], O[dt][1]); o.y = pk2c(O[dt][2], O[dt][3]); *(GAS v2u*)(ob + 32 * dt) = o; }
}

__device__ __forceinline__ void phase_moba_combine(Frame& F, unsigned char* ws) {
    const unsigned* SELM = (const unsigned*)(ws + WS_SELM); const float* PARTL = (const float*)(ws + WS_PARTL); const bf16* PARTO = (const bf16*)(ws + WS_PARTO);
    bf16* MIX = (bf16*)(ws + WS_MIX);
    int tid = F.tid; asm volatile("" : "+v"(tid));
    const int ch = tid & 15, ql = tid >> 4;
    for (int base = blockIdx.x * 64; base < BATCH * NHEAD * SEQ; base += F.G * 64) {
        v4u acc_w[2][4]; float lw[2][4]; int ns[2]; size_t idx[2];
#pragma unroll
        for (int k = 0; k < 2; ++k) {
            idx[k] = (size_t)base + 32 * k + ql;
            ns[k] = __builtin_popcount(SELM[idx[k]]);
#pragma unroll
            for (int s = 0; s < 4; ++s) { const bool ok = (s == 3) || (s < ns[k]);
                lw[k][s] = ok ? PARTL[idx[k] * 4 + s] : 0.f;
                acc_w[k][s] = ok ? *(const GAS v4u*)(PARTO + (idx[k] * 4 + s) * HD + 8 * ch) : (v4u){0u, 0u, 0u, 0u}; }
        }
#pragma unroll
        for (int k = 0; k < 2; ++k) {
            float o[8] = {0.f, 0.f, 0.f, 0.f, 0.f, 0.f, 0.f, 0.f}; float l = 0.f;
#pragma unroll
            for (int s = 0; s < 4; ++s) { float x[8]; unpack8(acc_w[k][s], x); l += lw[k][s];
#pragma unroll
                for (int e = 0; e < 8; ++e) o[e] += x[e]; }
            const float inv = 1.0f / l;
            const int bh = (int)(idx[k] / SEQ), q = (int)(idx[k] % SEQ), b = bh / NHEAD, h = bh % NHEAD;
            v4u w; w.x = pk2c(o[0] * inv, o[1] * inv); w.y = pk2c(o[2] * inv, o[3] * inv); w.z = pk2c(o[4] * inv, o[5] * inv); w.w = pk2c(o[6] * inv, o[7] * inv);
            *(GAS v4u*)(MIX + ((size_t)b * SEQ + q) * D + MC_A + h * HD + 8 * ch) = w;
        }
    }
}
#ifndef DUP_SCAN
#define DUP_SCAN 0
#endif
#ifndef DUP_QUEUE
#define DUP_QUEUE 0
#endif
constexpr int N_SWA_UNITS = BATCH * 2 * (SEQ / SWA_W), N_OWN_UNITS = BATCH * NHEAD * MOBA_NB * 2;
__device__ __forceinline__ void phase_mixers(Frame& F, const LayerW& L, unsigned char* ws, int layer, int rep) {
    constexpr int NSCAN = 2 * BATCH * NHEAD;
    const bool scanwg = blockIdx.x < NSCAN;
    gu32* gatectr = F.ctl + CW_GATE + 64 * layer;
    if (rep == 0 && !scanwg) {
        const int nwk = F.G - NSCAN, wk = blockIdx.x - NSCAN, per = (BATCH * NHEAD * MOBA_NB * 2 + nwk - 1) / nwk;
        int staged = -1;
        for (int u = wk * per; u < BATCH * NHEAD * MOBA_NB * 2 && u < (wk + 1) * per; ++u) {
            const int bh = u / (MOBA_NB * 2), r = u % (MOBA_NB * 2);
            moba_gate_unit(F, bh / NHEAD, bh % NHEAD, r >> 1, r & 1, layer, ws, staged != bh);
            staged = bh;
        }
        asm volatile("s_waitcnt vmcnt(0)" ::: "memory");
        __syncthreads();
        if (F.tid == 0) { __builtin_amdgcn_fence(__ATOMIC_RELEASE, "agent"); asm volatile("s_waitcnt vmcnt(0)" ::: "memory");
            __hip_atomic_fetch_add(gatectr, 1u, __ATOMIC_RELAXED, __HIP_MEMORY_SCOPE_AGENT); }
    }
    if (scanwg) for (int r3 = 0; r3 < (DUP_SCAN ? 2 : 1); ++r3) { gdn_scan_task(F, blockIdx.x >> 1, blockIdx.x & 1, ws); __syncthreads(); }
    LAS unsigned char* LB = F.lds + RING_OFF;
    volatile LAS unsigned* qw = (volatile LAS unsigned*)(LB + AT_MISC);
    volatile LAS unsigned* pref = (volatile LAS unsigned*)(LB + AT_PREF);
    gu32* cntp = F.ctl + CW_CNT + layer * N_LISTS;
    for (int r4 = 0; r4 < (DUP_QUEUE ? 2 : 1); ++r4) {
    gu32* head = F.ctl + CW_QUEUE + 64 * (layer * 2 + rep + 8 * r4);
#define QUEUE_FETCH(u_) do { __syncthreads();                          \
        if (F.tid == 0) *qw = __hip_atomic_fetch_add(head, 1u, __ATOMIC_RELAXED, __HIP_MEMORY_SCOPE_AGENT); \
        __syncthreads(); u_ = __builtin_amdgcn_readfirstlane((int)*qw); } while (0)
    int u; QUEUE_FETCH(u);
    while (u < N_OWN_UNITS) { const int r = u % (BATCH * NHEAD * 2), blk = MOBA_NB - 1 - u / (BATCH * NHEAD * 2), bh = r >> 1; moba_own_unit(F, bh / NHEAD, bh % NHEAD, blk, 1 - (r & 1), ws); QUEUE_FETCH(u); }
    if (F.tid == 0) {
        const unsigned want = (unsigned)(F.G - NSCAN); unsigned sp = 0u;
        while (__hip_atomic_load(gatectr, __ATOMIC_RELAXED, __HIP_MEMORY_SCOPE_AGENT) < want) { __builtin_amdgcn_s_sleep(2); if (++sp > (1u << 22)) break; }
        __builtin_amdgcn_fence(__ATOMIC_ACQUIRE, "agent"); asm volatile("s_waitcnt vmcnt(0)" ::: "memory");
    }
    __syncthreads();
    {
        const int t = F.tid; const unsigned cn = __hip_atomic_load(cntp + t, __ATOMIC_RELAXED, __HIP_MEMORY_SCOPE_AGENT);
        unsigned x = (cn + 127u) >> 7;
#pragma unroll
        for (int o = 1; o < 64; o <<= 1) { const unsigned y = (unsigned)__shfl_up((int)x, o); if (F.lane >= o) x += y; }
        if (F.lane == 63) pref[512 + F.wave] = x;
        __syncthreads();
        unsigned add = 0u;
        for (int w = 0; w < F.wave; ++w) add += pref[512 + w];
        pref[t] = x + add;
    }
    __syncthreads();
    const int total = (int)pref[511];
    while (u < N_OWN_UNITS + total + N_SWA_UNITS) {
        if (u < N_OWN_UNITS + total) {
            const int ug = u - N_OWN_UNITS;
            int lo = 0, hi = N_LISTS - 1;
            while (lo < hi) { const int mid = (lo + hi) >> 1; if ((int)pref[mid] > ug) hi = mid; else lo = mid + 1; }
            const int li = __builtin_amdgcn_readfirstlane(lo);
            const int j = ug - (li ? (int)pref[li - 1] : 0);
            const int cn = (int)__hip_atomic_load(cntp + li, __ATOMIC_RELAXED, __HIP_MEMORY_SCOPE_AGENT);
            moba_gather_unit(F, li, __builtin_amdgcn_readfirstlane(j), __builtin_amdgcn_readfirstlane(cn), ws);
        } else { const int v = u - N_OWN_UNITS - total; const int nq = v % (SEQ / SWA_W), bk = v / (SEQ / SWA_W); swa_unit(F, bk >> 1, bk & 1, nq, L.swa_sinks, ws); }
        QUEUE_FETCH(u);
    }
#undef QUEUE_FETCH
    }
}
__device__ __forceinline__ void phase_gdn_out(Frame& F, const LayerW& L, unsigned char* ws) {
    const bf16* PROJ = (const bf16*)(ws + WS_PROJ); const float* GO = (const float*)(ws + WS_GO); bf16* MIX = (bf16*)(ws + WS_MIX);
    const int gw = F.vcu * NWAVES + F.wave, NGW = F.G * NWAVES;
    int lane = F.lane; asm volatile("" : "+v"(lane));
    const float g0 = L.gdn_onorm[2 * lane], g1 = L.gdn_onorm[2 * lane + 1];
    for (int m = gw; m < M; m += NGW) {
        typedef float f32x2g __attribute__((ext_vector_type(2)));
        f32x2g o[NHEAD]; unsigned zw[NHEAD];
#pragma unroll
        for (int h = 0; h < NHEAD; ++h) { o[h] = *(const GAS f32x2g*)(GO + (size_t)m * GWID + h * HD + 2 * lane); zw[h] = *(const GAS unsigned*)(PROJ + (size_t)m * NIN + PC_GZ + h * HD + 2 * lane); }
#pragma unroll
        for (int h = 0; h < NHEAD; ++h) {
            const float r = __builtin_amdgcn_rsqf(grp_sum(row16_sum(o[h].x * o[h].x + o[h].y * o[h].y)) * (1.0f / HD) + EPS);
            const float z0 = bf_lo(zw[h]), z1 = bf_hi(zw[h]);
            *(GAS unsigned*)(MIX + (size_t)m * D + MC_B + h * HD + 2 * lane) = pk2(o[h].x * r * g0 * z0 * __builtin_amdgcn_rcpf(1.0f + __expf(-z0)), o[h].y * r * g1 * z1 * __builtin_amdgcn_rcpf(1.0f + __expf(-z1)));
        }
    }
}

#ifndef SKIP_P0
#define SKIP_P0 0
#endif
#ifndef SKIP_P1
#define SKIP_P1 0
#endif
#ifndef SKIP_P2
#define SKIP_P2 0
#endif
#ifndef SKIP_P3
#define SKIP_P3 0
#endif
#ifndef SKIP_P4
#define SKIP_P4 0
#endif
#ifndef SKIP_P5
#define SKIP_P5 0
#endif
#ifndef SKIP_P6
#define SKIP_P6 0
#endif
#ifndef SKIP_P7
#define SKIP_P7 0
#endif
#ifndef SKIP_P8
#define SKIP_P8 0
#endif
#ifndef SKIP_P9
#define SKIP_P9 0
#endif
#ifndef DUP_CHUNKPREP
#define DUP_CHUNKPREP 0
#endif
#ifndef DUP_PREPMOBA
#define DUP_PREPMOBA 0
#endif
#ifndef DUP_PREPTOK
#define DUP_PREPTOK 0
#endif
#ifndef DUP_P0
#define DUP_P0 0
#endif
#ifndef DUP_P1
#define DUP_P1 0
#endif
#ifndef DUP_P2
#define DUP_P2 0
#endif
#ifndef DUP_P3
#define DUP_P3 0
#endif
#ifndef DUP_P4
#define DUP_P4 0
#endif
#ifndef DUP_P5
#define DUP_P5 0
#endif
#ifndef DUP_P6
#define DUP_P6 0
#endif
#ifndef DUP_P7
#define DUP_P7 0
#endif
#ifndef DUP_P8
#define DUP_P8 0
#endif
#ifndef DUP_P9
#define DUP_P9 0
#endif
struct Args { const float* in[18]; float* out; unsigned char* ws; int ph_lo, ph_hi, li, pad; };
constexpr int PH_PER_LAYER = 9, N_PHASES = DEPTH * PH_PER_LAYER;
#ifndef MK_N_LAUNCHES
#define MK_N_LAUNCHES 1
#endif

__global__ void __launch_bounds__(NWAVES * 64, 2) hymba_fwd(Args args) {
    extern __shared__ __attribute__((aligned(16))) unsigned char lds[];
    Frame F;
    F.lds = (LAS unsigned char*)lds;
    F.MISC = (volatile LAS unsigned*)(F.lds + MISC_OFF);
    F.tid = threadIdx.x; F.lane = F.tid & 63; F.wave = __builtin_amdgcn_readfirstlane(F.tid >> 6);
    F.G = gridDim.x; { const int bx = blockIdx.x; F.vcu = (F.G % 8 == 0) ? (bx % 8) * (F.G / 8) + bx / 8 : bx; }
    F.ctl = (gu32*)(args.ws + WS_CTL);
    for (int u = F.tid; u < (LDS_BYTES - LDSCTL_OFF) / 4; u += NWAVES * 64) ((LAS unsigned*)(F.lds + LDSCTL_OFF))[u] = 0u;
    __syncthreads();
    XcdBarrier bar = xcd_barrier_post((unsigned*)(F.ctl + CW_BAR) + args.li * XCD_BAR_WORDS, F.MISC + 8);
    const int lo = args.ph_lo, hi = args.ph_hi;
#define IN(k) (lo <= (k) && (k) < hi)
#define SEAM(k) do { if (IN(k) && IN((k) + 1)) xcd_barrier(bar); } while (0)

    typedef const __attribute__((address_space(4))) Args* KArgs;
#define PHASE_BEGIN() do { int t_ = threadIdx.x; asm volatile("" : "+v"(t_)); F.tid = t_; F.lane = t_ & 63; F.wave = __builtin_amdgcn_readfirstlane(t_ >> 6); F.G = gridDim.x; \
        { const int bx_ = blockIdx.x; F.vcu = (F.G % 8 == 0) ? (bx_ % 8) * (F.G / 8) + bx_ / 8 : bx_; } } while (0)
#define KA() ({ PHASE_BEGIN(); KArgs _p = (KArgs)__builtin_amdgcn_kernarg_segment_ptr(); asm volatile("" : "+s"(_p)); _p; })
#define MAKE_L(L, ap, layer) LayerW L; { \
        L.norm_mix = ap->in[1] + (size_t)layer * D; L.w_in = ap->in[2] + (size_t)layer * D * IN_REAL; L.moba_qn = ap->in[3] + layer * HD; L.moba_kn = ap->in[4] + layer * HD; \
        L.gdn_conv = ap->in[5] + (size_t)layer * 4 * 3 * GWID; L.gdn_alog = ap->in[6] + layer * NHEAD; L.gdn_dtb = ap->in[7] + layer * NHEAD; L.gdn_onorm = ap->in[8] + layer * HD; \
        L.sc_conv = ap->in[9] + (size_t)layer * 3 * GWID; L.swa_qn = ap->in[10] + layer * 64; L.swa_kn = ap->in[11] + layer * 64; L.swa_sinks = ap->in[12] + layer * 16; \
        L.w_out = ap->in[13] + (size_t)layer * D * D; L.norm_ffn = ap->in[14] + (size_t)layer * D; L.w_gate = ap->in[15] + (size_t)layer * D * DFF; L.w_up = ap->in[16] + (size_t)layer * D * DFF; \
        L.w_down = ap->in[17] + (size_t)layer * DFF * D; }
    for (int layer = 0; layer < DEPTH; ++layer) {
        const int pb = layer * PH_PER_LAYER;
        for (int rep = 0; rep < (DUP_P0 ? 2 : 1); ++rep) {
        if (IN(pb + 0)) if (!SKIP_P0) { KArgs ap = KA(); unsigned char* ws = ap->ws; MAKE_L(L, ap, layer);
            phase_convert_weights(F, L, ws);
            if (layer == 0) phase_rmsnorm(F, ap->in[0], L.norm_mix, (bf16*)(ws + WS_H), (float*)(ws + WS_RSTD)); else phase_rstd(F, (const float*)(ws + WS_RS), (float*)(ws + WS_RSTD)); }
        SEAM(pb + 0);
        }
        for (int rep = 0; rep < (DUP_P1 ? 2 : 1); ++rep) {
        if (IN(pb + 1)) if (!SKIP_P1) { KArgs ap = KA(); unsigned char* ws = ap->ws;
            pg8::Gemm g{(const bf16*)(ws + WS_H), (const bf16*)(ws + WS_WIN), M, NIN, D}; pg8::StaticOrder S; S.init(M, NIN, F.G, (int)blockIdx.x);
            pg8::EpiBf16Plain E{(bf16*)(ws + WS_PROJ), NIN, (const float*)(ws + WS_RSTD)};
            pg8::gemm_phase<pg8::EpiBf16Plain, pg8::StaticOrder, true, true>(F.lds + RING_OFF, g, S, E); }
        SEAM(pb + 1);
        }
        for (int rep = 0; rep < (DUP_P2 ? 2 : 1); ++rep) {
        if (IN(pb + 2)) if (!SKIP_P2) { KArgs ap = KA(); unsigned char* ws = ap->ws; MAKE_L(L, ap, layer); for (int r2 = 0; r2 < (DUP_PREPMOBA ? 2 : 1); ++r2) { phase_prep_moba(F, L, ws); __syncthreads(); } for (int r2 = 0; r2 < (DUP_PREPTOK ? 2 : 1); ++r2) { phase_prep_tokens(F, L, ws); __syncthreads(); } for (int r2 = 0; r2 < (DUP_CHUNKPREP ? 2 : 1); ++r2) { phase_gdn_chunk_prep(F, ws, L.gdn_conv, L.gdn_alog, L.gdn_dtb); __syncthreads(); } }
        SEAM(pb + 2);
        }
        for (int rep = 0; rep < (DUP_P3 ? 2 : 1); ++rep) {
        if (IN(pb + 3)) if (!SKIP_P3) { KArgs ap = KA(); unsigned char* ws = ap->ws; MAKE_L(L, ap, layer); phase_mixers(F, L, ws, layer, rep); }
        SEAM(pb + 3);
        }
        for (int rep = 0; rep < (DUP_P4 ? 2 : 1); ++rep) {
        if (IN(pb + 4)) if (!SKIP_P4) { KArgs ap = KA(); unsigned char* ws = ap->ws; MAKE_L(L, ap, layer); phase_moba_combine(F, ws); phase_gdn_out(F, L, ws); }
        SEAM(pb + 4);
        }
        for (int rep = 0; rep < (DUP_P5 ? 2 : 1); ++rep) {
        if (IN(pb + 5)) if (!SKIP_P5) { KArgs ap = KA(); unsigned char* ws = ap->ws;
            pg8::Gemm g{(const bf16*)(ws + WS_MIX), (const bf16*)(ws + WS_WOUT), M, D, D}; pg8::StaticOrder S; S.init(M, D, F.G, (int)blockIdx.x, 2);
            pg8::EpiResF32 E{(layer == 0) ? ap->in[0] : ap->out, ap->out, D, (bf16*)(ws + WS_H), ap->in[14] + (size_t)layer * D, (float*)(ws + WS_RS)};
            pg8::gemm_phase<pg8::EpiResF32, pg8::StaticOrder, true, true>(F.lds + RING_OFF, g, S, E); }
        SEAM(pb + 5);
        }
        for (int rep = 0; rep < (DUP_P6 ? 2 : 1); ++rep) {
        if (IN(pb + 6)) if (!SKIP_P6) { KArgs ap = KA(); unsigned char* ws = ap->ws; phase_rstd(F, (const float*)(ws + WS_RS), (float*)(ws + WS_RSTD)); }
        SEAM(pb + 6);
        }
        for (int rep = 0; rep < (DUP_P7 ? 2 : 1); ++rep) {
        if (IN(pb + 7)) if (!SKIP_P7) { KArgs ap = KA(); unsigned char* ws = ap->ws;
            pg8::Gemm g{(const bf16*)(ws + WS_H), (const bf16*)(ws + WS_WGU), M, NGU, D}; pg8::StaticOrder S; S.init(M, NGU, F.G, (int)blockIdx.x);
            pg8::EpiSwiGLU E{(bf16*)(ws + WS_ACT), DFF, (const float*)(ws + WS_RSTD)};
            pg8::gemm_phase<pg8::EpiSwiGLU, pg8::StaticOrder, true, true>(F.lds + RING_OFF, g, S, E); }
        SEAM(pb + 7);
        }
        for (int rep = 0; rep < (DUP_P8 ? 2 : 1); ++rep) {
        if (IN(pb + 8)) if (!SKIP_P8) { KArgs ap = KA(); unsigned char* ws = ap->ws;
            pg8::Gemm g{(const bf16*)(ws + WS_ACT), (const bf16*)(ws + WS_WDN), M, D, DFF}; pg8::StaticOrder S; S.init(M, D, F.G, (int)blockIdx.x, 2);
            pg8::EpiResF32 E{ap->out, ap->out, D, (layer + 1 < DEPTH) ? (bf16*)(ws + WS_H) : (bf16*)nullptr, ap->in[1] + (size_t)(layer + 1 < DEPTH ? layer + 1 : layer) * D, (float*)(ws + WS_RS)};
            pg8::gemm_phase<pg8::EpiResF32, pg8::StaticOrder, true, true>(F.lds + RING_OFF, g, S, E); }
        SEAM(pb + 8);
        }
    }
#undef IN
#undef SEAM
}

extern "C" void kernel_launch(void* const* d_in, const int* in_sizes, int n_in, void* d_out, int out_size, void* d_ws, size_t ws_size, hipStream_t stream) {
    static int grid = 0;
    if (grid == 0) {
        if (n_in != 18 || in_sizes[0] != M * D || out_size != M * D || ws_size < WS_END5) { fprintf(stderr, "kernel_launch: unexpected shapes (n_in %d, in0 %d, out %d, ws %zu); nothing launched\n", n_in, n_in > 0 ? in_sizes[0] : -1, out_size, ws_size); grid = -1; return; }
        int dev = 0, cus = 0, per_cu = 0;
        if (hipGetDevice(&dev) != hipSuccess || hipDeviceGetAttribute(&cus, hipDeviceAttributeMultiprocessorCount, dev) != hipSuccess) { grid = -1; return; }
        if (hipFuncSetAttribute((const void*)hymba_fwd, hipFuncAttributeMaxDynamicSharedMemorySize, LDS_BYTES) != hipSuccess) { fprintf(stderr, "kernel_launch: hipFuncSetAttribute failed\n"); grid = -1; return; }
        if (hipOccupancyMaxActiveBlocksPerMultiprocessor(&per_cu, (const void*)hymba_fwd, NWAVES * 64, LDS_BYTES) != hipSuccess || per_cu < 1)
            fprintf(stderr, "kernel_launch: note: occupancy query reports %d workgroups per CU\n", per_cu);
        (void)hipGetLastError();
        grid = cus;
    }
    if (grid < 0) return;
    if (hipMemsetAsync((char*)d_ws + WS_CTL, 0, CTL_ZERO_BYTES, stream) != hipSuccess) return;
    Args a{};
    for (int i = 0; i < 18; ++i) a.in[i] = (const float*)d_in[i];
    a.out = (float*)d_out; a.ws = (unsigned char*)d_ws; a.pad = 0;
#if MK_N_LAUNCHES == 1
    a.ph_lo = 0; a.ph_hi = N_PHASES; a.li = 0;
    hipLaunchKernelGGL(hymba_fwd, dim3(grid), dim3(NWAVES * 64), LDS_BYTES, stream, a);
#else
    for (int p = 0; p < N_PHASES; ++p) { a.ph_lo = p; a.ph_hi = p + 1; a.li = 0;
        hipLaunchKernelGGL(hymba_fwd, dim3(grid), dim3(NWAVES * 64), LDS_BYTES, stream, a); }
#endif
}
```

```cpp
#include <hip/hip_runtime.h>
#include <cstdio>
#include <cstdint>
#include <cmath>
namespace pg8 {
#define PG8_LAS __attribute__((address_space(3)))
typedef unsigned short bf16_t;
typedef short bf16x8 __attribute__((ext_vector_type(8)));
typedef float f32x4 __attribute__((ext_vector_type(4)));
typedef unsigned u32x4 __attribute__((ext_vector_type(4)));
constexpr int BM = 256, BK = 64, HALF = 128, HTB = HALF * BK * 2  , STAGE_BYTES = 8 * HTB, NXCD = 8, WGM = 8;

__host__ __device__ __forceinline__ int lds_byte(int r, int c) { const int st = (r >> 4) * 2 + (c >> 5), rr = r & 15, cc = c & 31, ob = rr * 64 + cc * 2; return st * 1024 + (ob ^ (((ob >> 9) & 1) << 5)); }
__host__ __device__ __forceinline__ void stage_rc(int b, int& R, int& C) { const int st = b / 1024, sb = b % 1024, swz = sb ^ (((sb >> 9) & 1) << 5); R = (st >> 1) * 16 + swz / 64; C = (st & 1) * 32 + (swz % 64) / 2; }
__host__ __device__ __forceinline__ int perm32(int rho) { const int n = rho >> 4, i = rho & 15; return 8 * (i >> 2) + 4 * n + (i & 3); }

struct Unit { int pm, pn; };
struct Gemm { const bf16_t* A; const bf16_t* Bt; int M, N, K; };

struct StaticOrder {
    int nM, nN, nwg, G, c, wgm;
    __host__ __device__ void init(int M, int N, int G_, int c_, int wgm_ = WGM) { nM = M / BM; nN = N / BM; nwg = nM * nN; G = G_; c = c_; wgm = wgm_; }
    __host__ __device__ bool next(int i, Unit& u) const {
        const long L = (long)i * G + c; if (L >= nwg) return false;
        int wgid = (int)L; { const int q = nwg / NXCD, r = nwg % NXCD, xcd = wgid % NXCD, off = wgid / NXCD; wgid = (xcd < r ? xcd * (q + 1) : r * (q + 1) + (xcd - r) * q) + off; }
        const int nig = wgm * nN, gid = wgid / nig, fm = gid * wgm, gsz = (nM - fm) < wgm ? (nM - fm) : wgm;
        u.pm = fm + ((wgid % nig) % gsz); u.pn = (wgid % nig) / gsz; return true;
    }
    __device__ __forceinline__ void a_ready(const Unit&) const {}
    __device__ __forceinline__ void done(const Unit&) const {}
};

__device__ __forceinline__ unsigned cvt_pk_bf16(float lo, float hi) { unsigned r; asm volatile("v_cvt_pk_bf16_f32 %0, %1, %2" : "=v"(r) : "v"(lo), "v"(hi)); return r; }

struct EpiBf16Plain {
    static constexpr bool PERM = true, AFTER_DRAIN = false;
    bf16_t* O; int ldc; const float* rs;
    __device__ __forceinline__ void operator()(const f32x4 (&acc)[2][2][4][2], const Unit& u, int wr, int wc, int fr, int fq) const {
        const int row0 = u.pm * BM + wr * 64 + fr; const int col0 = u.pn * BM + wc * 32 + 8 * fq;
        float rr[2][4];
#pragma unroll
        for (int ai = 0; ai < 2; ++ai)
#pragma unroll
            for (int m = 0; m < 4; ++m) rr[ai][m] = rs[row0 + ai * HALF + m * 16];
#pragma unroll
        for (int ai = 0; ai < 2; ++ai)
#pragma unroll
            for (int m = 0; m < 4; ++m) { bf16_t* rowp = O + (size_t)(row0 + ai * HALF + m * 16) * ldc + col0; const float r = rr[ai][m];
#pragma unroll
                for (int bj = 0; bj < 2; ++bj) { const f32x4 v0 = acc[ai][bj][m][0] * r, v1 = acc[ai][bj][m][1] * r;
                    u32x4 w; w.x = cvt_pk_bf16(v0[0], v0[1]); w.y = cvt_pk_bf16(v0[2], v0[3]); w.z = cvt_pk_bf16(v1[0], v1[1]); w.w = cvt_pk_bf16(v1[2], v1[3]);
                    *(u32x4*)(rowp + bj * HALF) = w; } }
    }
};
struct EpiResF32 {
    static constexpr bool PERM = false, AFTER_DRAIN = false;
    const float* base; float* C; int ldc; bf16_t* XG; const float* gain; float* RS;
    __device__ __forceinline__ void operator()(const f32x4 (&acc)[2][2][4][2], const Unit& u, int wr, int wc, int fr, int fq) const {
        const int row0 = u.pm * BM + wr * 64 + fr, col0 = u.pn * BM + wc * 32 + 4 * fq;
        f32x4 gv[2][2];
        if (XG) {
#pragma unroll
            for (int bj = 0; bj < 2; ++bj)
#pragma unroll
                for (int n = 0; n < 2; ++n) gv[bj][n] = *(const f32x4*)(gain + col0 + bj * HALF + n * 16);
        }
#pragma unroll
        for (int ai = 0; ai < 2; ++ai)
#pragma unroll
        for (int mh = 0; mh < 2; ++mh) {
            f32x4 bs[2][2][2];
#pragma unroll
            for (int mm = 0; mm < 2; ++mm) { const size_t off = (size_t)(row0 + ai * HALF + (2 * mh + mm) * 16) * ldc + col0;
#pragma unroll
                for (int bj = 0; bj < 2; ++bj)
#pragma unroll
                    for (int n = 0; n < 2; ++n) bs[mm][bj][n] = *(const f32x4*)(base + off + bj * HALF + n * 16); }
#pragma unroll
            for (int mm = 0; mm < 2; ++mm) { const int m = 2 * mh + mm; const int row = row0 + ai * HALF + m * 16; const size_t off = (size_t)row * ldc + col0;
                float ss = 0.f;
#pragma unroll
                for (int bj = 0; bj < 2; ++bj)
#pragma unroll
                    for (int n = 0; n < 2; ++n) { const f32x4 v = acc[ai][bj][m][n] + bs[mm][bj][n]; *(f32x4*)(C + off + bj * HALF + n * 16) = v;
                        if (XG) { ss += (v[0] * v[0] + v[1] * v[1]) + (v[2] * v[2] + v[3] * v[3]); const f32x4 w = v * gv[bj][n];
                            unsigned lo = cvt_pk_bf16(w[0], w[1]), hi = cvt_pk_bf16(w[2], w[3]); *(unsigned long long*)(XG + off + bj * HALF + n * 16) = (unsigned long long)lo | ((unsigned long long)hi << 32); } }
                if (XG) { ss += __shfl_xor(ss, 16); ss += __shfl_xor(ss, 32); if (fq == 0) RS[(size_t)row * 64 + u.pn * 4 + wc] = ss; }
            }
            asm volatile("" ::: "memory");
        }
    }
};
struct EpiSwiGLU {
    static constexpr bool PERM = true, AFTER_DRAIN = false;
    bf16_t* O; int ldc; const float* rs;
    static __device__ __forceinline__ float sg(float g, float uu) { return g * uu * __builtin_amdgcn_rcpf(1.0f + __expf(-g)); }
    __device__ __forceinline__ void operator()(const f32x4 (&acc)[2][2][4][2], const Unit& u, int wr, int wc, int fr, int fq) const {
        const int row0 = u.pm * BM + wr * 64 + fr; const int col0 = u.pn * HALF + wc * 32 + 8 * fq;
        float rr[2][4];
#pragma unroll
        for (int ai = 0; ai < 2; ++ai)
#pragma unroll
            for (int m = 0; m < 4; ++m) rr[ai][m] = rs[row0 + ai * HALF + m * 16];
#pragma unroll
        for (int ai = 0; ai < 2; ++ai)
#pragma unroll
            for (int m = 0; m < 4; ++m) { bf16_t* rowp = O + (size_t)(row0 + ai * HALF + m * 16) * ldc + col0;
                const float r = rr[ai][m];
                const f32x4 g0 = acc[ai][0][m][0] * r, g1 = acc[ai][0][m][1] * r, u0 = acc[ai][1][m][0] * r, u1 = acc[ai][1][m][1] * r;
                u32x4 w; w.x = cvt_pk_bf16(sg(g0[0], u0[0]), sg(g0[1], u0[1])); w.y = cvt_pk_bf16(sg(g0[2], u0[2]), sg(g0[3], u0[3]));
                w.z = cvt_pk_bf16(sg(g1[0], u1[0]), sg(g1[1], u1[1])); w.w = cvt_pk_bf16(sg(g1[2], u1[2]), sg(g1[3], u1[3]));
                *(u32x4*)rowp = w; }
    }
};

template <class Epi, class Sched, bool ALIGN_EPI = false, bool SP2 = false>
__device__ __forceinline__ void gemm_phase(PG8_LAS unsigned char* lds, const Gemm g, const Sched& S, const Epi& E) {
    int tid_ = threadIdx.x; asm volatile("" : "+v"(tid_));
    const int tid = tid_, wid = __builtin_amdgcn_readfirstlane(tid >> 6), lane = tid & 63, wr = wid >> 2, wc = wid & 3, fr = lane & 15, fq = lane >> 4;
    const int K = g.K, nt = K / BK;
    unsigned voffA[2], voffB[2];
#pragma unroll
    for (int i = 0; i < 2; ++i) { int R, C; stage_rc(tid * 16 + i * 8192, R, C); const int Rb = Epi::PERM ? ((R & ~31) + perm32(R & 31)) : R;
        voffA[i] = (unsigned)(R * K + C) * 2u; voffB[i] = (unsigned)(Rb * K + C) * 2u; }
    const size_t kstep = (size_t)(BK * 2);
    const size_t hstep = (size_t)HALF * K * 2;
    const size_t tstep = 2 * hstep;
    const unsigned ldsw = (unsigned)wid * 1024u;
    const int aoff = lds_byte(wr * 64 + fr, fq * 8), boff = lds_byte(wc * 32 + fr, fq * 8);
#define PG8_SA(b, h) (((b) * 2 + (h)) * HTB)
#define PG8_SB(b, h) ((4 + (b) * 2 + (h)) * HTB)
#define PG8_STAGE(bufoff, gbase, voff) do { _Pragma("unroll") for (int _i = 0; _i < 2; ++_i) \
        __builtin_amdgcn_global_load_lds((const unsigned*)((const char*)(gbase) + (voff)[_i]), (PG8_LAS unsigned*)(lds + (bufoff) + ldsw + _i * 8192), 16, 0, 0); } while (0)
#define PG8_LDA(dst, b, h) do { _Pragma("unroll") for (int m = 0; m < 4; ++m) _Pragma("unroll") for (int k = 0; k < 2; ++k) dst[m][k] = *(const PG8_LAS bf16x8*)(lds + PG8_SA(b, h) + aoff + m * 2048 + k * 1024); } while (0)
#define PG8_LDB(dst, b, h) do { _Pragma("unroll") for (int n = 0; n < 2; ++n) _Pragma("unroll") for (int k = 0; k < 2; ++k) dst[n][k] = *(const PG8_LAS bf16x8*)(lds + PG8_SB(b, h) + boff + n * 2048 + k * 1024); } while (0)
#define PG8_MMA(ai, bj, At, Bt) do { __builtin_amdgcn_s_setprio(1); _Pragma("unroll") for (int m = 0; m < 4; ++m) _Pragma("unroll") for (int n = 0; n < 2; ++n) _Pragma("unroll") for (int k = 0; k < 2; ++k) \
        acc[ai][bj][m][n] = __builtin_amdgcn_mfma_f32_16x16x32_bf16(Bt[n][k], At[m][k], acc[ai][bj][m][n], 0, 0, 0); __builtin_amdgcn_s_setprio(0); } while (0)
#define PG8_WAIT_V(n) asm volatile("s_waitcnt vmcnt(" #n ")" ::: "memory")
#define PG8_WAIT_L(n) asm volatile("s_waitcnt lgkmcnt(" #n ")" ::: "memory")
#define PG8_BAR __builtin_amdgcn_s_barrier()
#define PG8_SCHED __builtin_amdgcn_sched_barrier(0)
    Unit cur, nxt; int ui = 0;
    if (!S.next(0, cur)) return;
    f32x4 acc[2][2][4][2];
#pragma unroll
    for (int a = 0; a < 2; ++a)
#pragma unroll
        for (int b = 0; b < 2; ++b)
#pragma unroll
            for (int m = 0; m < 4; ++m)
#pragma unroll
                for (int n = 0; n < 2; ++n) acc[a][b][m][n] = (f32x4){0.f, 0.f, 0.f, 0.f};
    bf16x8 At[4][2], B0[2][2], B1[2][2];
    const char* cA = (const char*)g.A + (size_t)cur.pm * tstep; const char* cB = (const char*)g.Bt + (size_t)cur.pn * tstep;
    S.a_ready(cur);
    if constexpr (SP2) {
        PG8_STAGE(PG8_SB(0, 0), cB, voffB); PG8_STAGE(PG8_SB(0, 1), cB + hstep, voffB); PG8_STAGE(PG8_SA(0, 0), cA, voffA); PG8_STAGE(PG8_SA(0, 1), cA + hstep, voffA);
        if (wr == 1) PG8_BAR;
        PG8_WAIT_V(2); PG8_BAR;
        PG8_STAGE(PG8_SB(1, 0), cB + kstep, voffB); PG8_STAGE(PG8_SA(1, 0), cA + kstep, voffA); PG8_STAGE(PG8_SB(1, 1), cB + hstep + kstep, voffB);
        PG8_WAIT_V(6); PG8_BAR;
    } else {
        PG8_STAGE(PG8_SB(0, 0), cB, voffB); PG8_STAGE(PG8_SA(0, 0), cA, voffA); PG8_STAGE(PG8_SB(0, 1), cB + hstep, voffB); PG8_STAGE(PG8_SA(0, 1), cA + hstep, voffA);
        if (wr == 1) PG8_BAR;
        PG8_WAIT_V(4); PG8_BAR;
        PG8_STAGE(PG8_SB(1, 0), cB + kstep, voffB); PG8_STAGE(PG8_SA(1, 0), cA + kstep, voffA); PG8_STAGE(PG8_SB(1, 1), cB + hstep + kstep, voffB);
        PG8_WAIT_V(6); PG8_BAR;
    }
    for (;;) {
        const bool has_next = S.next(ui + 1, nxt);
        const char* nA = has_next ? (const char*)g.A + (size_t)nxt.pm * tstep : cA; const char* nB = has_next ? (const char*)g.Bt + (size_t)nxt.pn * tstep : cB;
        for (int t = 0; t < nt; t += 2) {
            const bool last = (t == nt - 2);
            const char* a1 = cA + (size_t)(t + 1) * kstep;
            const char* a2 = last ? nA : cA + (size_t)(t + 2) * kstep; const char* b2 = last ? nB : cB + (size_t)(t + 2) * kstep;
            const char* a3 = a2 + kstep; const char* b3 = b2 + kstep;
            if (last && has_next) S.a_ready(nxt);
            if constexpr (SP2) {
            PG8_LDB(B0, 0, 0); PG8_LDB(B1, 0, 1); PG8_SCHED; PG8_LDA(At, 0, 0); PG8_STAGE(PG8_SA(1, 1), a1 + hstep, voffA);
            PG8_WAIT_V(8); PG8_WAIT_L(0); PG8_BAR; PG8_MMA(0, 0, At, B0); PG8_MMA(0, 1, At, B1); PG8_BAR; PG8_SCHED;
            PG8_LDA(At, 0, 1); PG8_STAGE(PG8_SB(0, 0), b2, voffB); PG8_STAGE(PG8_SB(0, 1), b2 + hstep, voffB); PG8_STAGE(PG8_SA(0, 0), a2, voffA);
            PG8_WAIT_V(8); PG8_WAIT_L(0); PG8_BAR; PG8_MMA(1, 0, At, B0); PG8_MMA(1, 1, At, B1); PG8_BAR; PG8_SCHED;
            PG8_LDB(B0, 1, 0); PG8_LDB(B1, 1, 1); PG8_SCHED; PG8_LDA(At, 1, 0); PG8_STAGE(PG8_SA(0, 1), a2 + hstep, voffA);
            PG8_WAIT_V(8); PG8_WAIT_L(0); PG8_BAR; PG8_MMA(0, 0, At, B0); PG8_MMA(0, 1, At, B1); PG8_BAR; PG8_SCHED;
            PG8_LDA(At, 1, 1); PG8_STAGE(PG8_SB(1, 0), b3, voffB); PG8_STAGE(PG8_SB(1, 1), b3 + hstep, voffB); PG8_STAGE(PG8_SA(1, 0), a3, voffA);
            PG8_WAIT_V(8); PG8_WAIT_L(0); PG8_BAR; PG8_MMA(1, 0, At, B0); PG8_MMA(1, 1, At, B1); PG8_BAR; PG8_SCHED;
            } else {
            PG8_LDB(B0, 0, 0); PG8_SCHED; PG8_LDA(At, 0, 0); PG8_STAGE(PG8_SA(1, 1), a1 + hstep, voffA);
            PG8_WAIT_L(8); PG8_BAR; PG8_WAIT_L(0); PG8_MMA(0, 0, At, B0); PG8_BAR; PG8_SCHED;
            PG8_LDB(B1, 0, 1); PG8_STAGE(PG8_SB(0, 0), b2, voffB);
            PG8_BAR; PG8_WAIT_L(0); PG8_MMA(0, 1, At, B1); PG8_BAR;
            PG8_LDA(At, 0, 1); PG8_STAGE(PG8_SA(0, 0), a2, voffA);
            PG8_BAR; PG8_WAIT_L(0); PG8_MMA(1, 0, At, B0); PG8_BAR; PG8_SCHED;
            PG8_STAGE(PG8_SB(0, 1), b2 + hstep, voffB);
            PG8_WAIT_V(6); PG8_BAR; PG8_MMA(1, 1, At, B1); PG8_BAR;
            PG8_LDB(B0, 1, 0); PG8_SCHED; PG8_LDA(At, 1, 0); PG8_STAGE(PG8_SA(0, 1), a2 + hstep, voffA);
            PG8_WAIT_L(8); PG8_BAR; PG8_WAIT_L(0); PG8_MMA(0, 0, At, B0); PG8_BAR; PG8_SCHED;
            PG8_LDB(B1, 1, 1); PG8_STAGE(PG8_SB(1, 0), b3, voffB);
            PG8_BAR; PG8_WAIT_L(0); PG8_MMA(0, 1, At, B1); PG8_BAR;
            PG8_LDA(At, 1, 1); PG8_STAGE(PG8_SA(1, 0), a3, voffA);
            PG8_BAR; PG8_WAIT_L(0); PG8_MMA(1, 0, At, B0); PG8_BAR; PG8_SCHED;
            PG8_STAGE(PG8_SB(1, 1), b3 + hstep, voffB);
            PG8_WAIT_V(6); PG8_BAR; PG8_MMA(1, 1, At, B1); PG8_BAR;
            }
        }
        if constexpr (ALIGN_EPI) { if (wr == 0) PG8_BAR; }
        if constexpr (!Epi::AFTER_DRAIN) { E(acc, cur, wr, wc, fr, fq); S.done(cur); }
        if (!has_next) break;
#pragma unroll
        for (int a = 0; a < 2; ++a)
#pragma unroll
            for (int b = 0; b < 2; ++b)
#pragma unroll
                for (int m = 0; m < 4; ++m)
#pragma unroll
                    for (int n = 0; n < 2; ++n) acc[a][b][m][n] = (f32x4){0.f, 0.f, 0.f, 0.f};
        cur = nxt; cA = nA; cB = nB; ++ui;
        if constexpr (ALIGN_EPI) { if (wr == 1) PG8_BAR; }
    }
    PG8_WAIT_V(0);
    if constexpr (!ALIGN_EPI) { if (wr == 0) PG8_BAR; }
    PG8_BAR;
    if constexpr (Epi::AFTER_DRAIN) { E.fused(acc, cur, wr, wc, fr, fq, lds, wid, lane); S.done(cur); }
#undef PG8_SA
#undef PG8_SB
#undef PG8_STAGE
#undef PG8_LDA
#undef PG8_LDB
#undef PG8_MMA
#undef PG8_WAIT_V
#undef PG8_WAIT_L
#undef PG8_BAR
#undef PG8_SCHED
}
}
#define GAS __attribute__((address_space(1)))
#define LAS __attribute__((address_space(3)))
typedef unsigned short bf16;
typedef unsigned v4u __attribute__((ext_vector_type(4)));
typedef float f32x4 __attribute__((ext_vector_type(4)));
typedef short bf16x8 __attribute__((ext_vector_type(8)));
typedef GAS unsigned gu32;
typedef GAS unsigned long long gu64;
#define RLX_AGENT __ATOMIC_RELAXED, __HIP_MEMORY_SCOPE_AGENT
#define LDS_WAIT() asm volatile("s_waitcnt lgkmcnt(0)" ::: "memory")
#define VM_WAIT() asm volatile("s_waitcnt vmcnt(0)" ::: "memory")
__device__ __forceinline__ unsigned long long rt() { return __builtin_amdgcn_s_memrealtime(); }
__device__ __forceinline__ unsigned f2bf(float f) { unsigned u = __builtin_bit_cast(unsigned, f); return (u + 0x7fffu + ((u >> 16) & 1u)) >> 16; }
__device__ __forceinline__ unsigned pk2(float lo, float hi) { return f2bf(lo) | (f2bf(hi) << 16); }
typedef float f32x2_t_ __attribute__((ext_vector_type(2))); typedef __bf16 bf16x2_t_ __attribute__((ext_vector_type(2)));
__device__ __forceinline__ unsigned pk2c(float lo, float hi) { const f32x2_t_ v = {lo, hi}; return __builtin_bit_cast(unsigned, __builtin_convertvector(v, bf16x2_t_)); }

#define XB_TMO      128
#define XB_XCNT(j)  (256  + 64 * (j))
#define XB_XSUB(j)  (1280 + 64 * (j))
#define XB_XGEN(j)  (2304 + 64 * (j))
#define XB_TOP      3328
#define XB_TOPGEN   3392
#define XCD_BAR_WORDS 3456
#define XB_SPIN_CAP (1u << 21)

__device__ __forceinline__ unsigned xb_ld(unsigned* p)              { return __hip_atomic_load(p, __ATOMIC_RELAXED, __HIP_MEMORY_SCOPE_AGENT); }
__device__ __forceinline__ unsigned xb_add(unsigned* p, unsigned v) { return __hip_atomic_fetch_add(p, v, __ATOMIC_RELAXED, __HIP_MEMORY_SCOPE_AGENT); }
__device__ __forceinline__ unsigned xb_xcc_id() { return (unsigned)__builtin_amdgcn_s_getreg((3 << 11) | 20) & 0xFu; }
#define XB_SPIN(cond, bar) do { unsigned _sp = 0; while (cond) { __builtin_amdgcn_s_sleep(1); \
    if ((++_sp & 255u) == 0u) { if (xb_ld(&(bar)[XB_TMO])) break; if (_sp > XB_SPIN_CAP) { atomicAdd(&(bar)[XB_TMO], 1u); break; } } } } while (0)

struct XcdBarrier {
    unsigned* bar; unsigned x;
    volatile LAS unsigned* st;
};

__device__ __forceinline__ XcdBarrier xcd_barrier_post(unsigned* bar, volatile LAS unsigned* st) {
    XcdBarrier b; b.bar = bar; b.x = xb_xcc_id(); b.st = st;
    if (threadIdx.x == 0) (void)xb_add(&bar[XB_XCNT(b.x)], 1u);
    return b;
}
__device__ __forceinline__ void xcd_barrier_complete(unsigned* bar, unsigned x, unsigned& nloc, unsigned& nx) {
    const unsigned G = gridDim.x * gridDim.y * gridDim.z;
    unsigned sum, cnt, mine, sp = 0u;
    for (;;) {
        sum = 0u; cnt = 0u; mine = 0u;
#pragma unroll
        for (unsigned j = 0; j < 16; ++j) { const unsigned c = xb_ld(&bar[XB_XCNT(j)]); sum += c; cnt += (c > 0u) ? 1u : 0u; mine = (j == x) ? c : mine; }
        if (sum == G) break;
        __builtin_amdgcn_s_sleep(1);
        if ((++sp & 255u) == 0u) { if (xb_ld(&bar[XB_TMO])) break; if (sp > XB_SPIN_CAP) { atomicAdd(&bar[XB_TMO], 1u); break; } }
    }
    nloc = mine > 0u ? mine : 1u; nx = cnt > 0u ? cnt : 1u;
}

__device__ __forceinline__ void xcd_barrier(const XcdBarrier& b) {
    asm volatile("s_waitcnt vmcnt(0)" ::: "memory");
    __syncthreads();
    if (threadIdx.x == 0) {
        unsigned* bar = b.bar;
        __builtin_amdgcn_s_waitcnt(0);
        unsigned nloc = b.st[0], nx = b.st[1];
        if (nloc == 0u) { xcd_barrier_complete(bar, b.x, nloc, nx); b.st[0] = nloc; b.st[1] = nx; }
        const unsigned old = xb_add(&bar[XB_XSUB(b.x)], 1u);
        const unsigned gen = old / nloc;
        if (old + 1u == (gen + 1u) * nloc) {
            __builtin_amdgcn_fence(__ATOMIC_RELEASE, "agent");
            asm volatile("s_waitcnt vmcnt(0)" ::: "memory");
            const unsigned og = xb_add(&bar[XB_TOP], 1u);
            const unsigned tg = og / nx;
            if (og + 1u == (tg + 1u) * nx) xb_add(&bar[XB_TOPGEN], 1u);
            else XB_SPIN(xb_ld(&bar[XB_TOPGEN]) == tg, bar);
            __builtin_amdgcn_fence(__ATOMIC_ACQUIRE, "agent");
            xb_add(&bar[XB_XGEN(b.x)], 1u);
            asm volatile("s_waitcnt vmcnt(0)" ::: "memory");
        } else {
            XB_SPIN(xb_ld(&bar[XB_XGEN(b.x)]) == gen, bar);
            __builtin_amdgcn_fence(__ATOMIC_ACQUIRE, "agent");
            asm volatile("s_waitcnt vmcnt(0)" ::: "memory");
        }
    }
    __syncthreads();
}
constexpr int NWAVES = 8;
constexpr int BATCH = 2, SEQ = 8192, M = BATCH * SEQ, D = 4096, DEPTH = 2;
constexpr int GWID = 1024, HD = 128, NHEAD = 8;
constexpr int IN_REAL = 11536, NIN = 11776, DFF = 11008, NGU = 2 * DFF;
constexpr float EPS = 1e-6f;
constexpr int PC_MQ = 0, PC_MK = 1024, PC_MV = 2048, PC_GQ = 3072, PC_GK = 4096, PC_GV = 5120, PC_GZ = 6144, PC_SCB = 7168, PC_SCC = 8192, PC_SCX = 9216,
              PC_SQ = 10240, PC_SK = 11264, PC_SV = 11392, PC_GA = 11520, PC_GB = 11528;
constexpr int MC_A = 0, MC_B = 1024, MC_C = 2048, MC_D = 3072;
constexpr int MOBA_BLK = 256, MOBA_NB = SEQ / MOBA_BLK, SWA_W = 128;

constexpr size_t MiB = 1u << 20;
constexpr size_t WS_CTL = 0, CTL_ZERO_BYTES = 1 * MiB;
constexpr size_t WS_WIN = 2 * MiB, WS_WOUT = 94 * MiB, WS_WGU = 126 * MiB, WS_WDN = 298 * MiB;
constexpr size_t WS_H = 384 * MiB, WS_MIX = 512 * MiB, WS_PROJ = 640 * MiB, WS_ACT = WS_PROJ;
constexpr size_t WS_QN = 1008 * MiB, WS_KN = 1040 * MiB, WS_SQN = 1072 * MiB, WS_SKN = 1104 * MiB, WS_KMEAN = 1108 * MiB;
constexpr size_t WS_GQ = 1110 * MiB, WS_GK = 1142 * MiB, WS_GV = 1174 * MiB, WS_GG = 1206 * MiB, WS_GBETA = WS_GG + 512 * 1024, WS_GO = 1208 * MiB, WS_END = 1272 * MiB;
static_assert(WS_WIN + (size_t)NIN * D * 2 <= WS_WOUT && WS_WOUT + (size_t)D * D * 2 <= WS_WGU && WS_WGU + (size_t)NGU * D * 2 <= WS_WDN && WS_WDN + (size_t)D * DFF * 2 <= WS_H, "weights map");
static_assert(WS_PROJ + (size_t)M * NIN * 2 <= WS_QN && WS_GO + (size_t)M * GWID * 4 <= WS_END, "ws map");
constexpr int CW_BAR = 4096;
constexpr size_t WS_RS = 1456 * MiB, WS_RSTD = 1460 * MiB, WS_END4 = 1461 * MiB;
constexpr size_t WS_VTG = 1420 * MiB, WS_SVT = 1452 * MiB, WS_END3 = 1456 * MiB;

constexpr int RING_OFF = 0, RING_BYTES = 131072;
constexpr int LDSCTL_OFF = RING_BYTES, MISC_OFF = LDSCTL_OFF + 320;
constexpr int LDS_BYTES = 147456;

struct Frame {
    LAS unsigned char* lds;
    volatile LAS unsigned* MISC;
    gu32* ctl;
    int tid, lane, wave;
    int vcu, G;
};

__device__ __forceinline__ float wave_sum(float v) {
#pragma unroll
    for (int o = 1; o < 64; o <<= 1) v += __shfl_xor(v, o);
    return v;
}
__device__ __forceinline__ float wave_max(float v) {
#pragma unroll
    for (int o = 1; o < 64; o <<= 1) v = fmaxf(v, __shfl_xor(v, o));
    return v;
}
__device__ __forceinline__ float bf_lo(unsigned w) { return __builtin_bit_cast(float, w << 16); }
__device__ __forceinline__ float bf_hi(unsigned w) { return __builtin_bit_cast(float, w & 0xffff0000u); }
__device__ __forceinline__ float bf1(bf16 h) { return __builtin_bit_cast(float, ((unsigned)h) << 16); }
__device__ __forceinline__ float silu_f(float x) { return x / (1.0f + __expf(-x)); }

template <class SrcCol>
__device__ __forceinline__ void transpose_item(const float* W, int K, int N, bf16* WT, LAS float* scr, int kb, int nb, int lane, SrcCol srcCol) {
    const int k0 = 64 * kb, n0 = 32 * nb;
    const int c4 = (lane & 7) * 4, sc = srcCol(n0 + c4);
    f32x4 v[8];
#pragma unroll
    for (int i = 0; i < 8; ++i) { const int kk = 8 * i + (lane >> 3); v[i] = (sc >= 0) ? *(const GAS f32x4*)(W + (size_t)(k0 + kk) * N + sc) : (f32x4){0.f, 0.f, 0.f, 0.f}; }
#pragma unroll
    for (int i = 0; i < 8; ++i) { const int kk = 8 * i + (lane >> 3); LAS float* d = scr + kk * 33 + c4; d[0] = v[i].x; d[1] = v[i].y; d[2] = v[i].z; d[3] = v[i].w; }
    LDS_WAIT(); asm volatile("" ::: "memory");
    const int c = lane & 7;
#pragma unroll
    for (int j = 0; j < 4; ++j) { const int n = (lane >> 3) + 8 * j; const LAS float* s = scr + (8 * c) * 33 + n;
        v4u o; o.x = pk2(s[0 * 33], s[1 * 33]); o.y = pk2(s[2 * 33], s[3 * 33]); o.z = pk2(s[4 * 33], s[5 * 33]); o.w = pk2(s[6 * 33], s[7 * 33]);
        *(GAS v4u*)(WT + (size_t)(n0 + n) * K + k0 + 8 * c) = o; }
    LDS_WAIT(); asm volatile("" ::: "memory");
}

struct LayerW {
    const float *norm_mix, *w_in, *moba_qn, *moba_kn, *gdn_conv, *gdn_alog, *gdn_dtb, *gdn_onorm, *sc_conv, *swa_qn, *swa_kn, *swa_sinks, *w_out, *norm_ffn, *w_gate, *w_up, *w_down;
};

__device__ __forceinline__ void phase_convert_weights(Frame& F, const LayerW& L, unsigned char* ws) {
    LAS float* scr = (LAS float*)(F.lds + RING_OFF + F.wave * 16384);
    const int gw = F.vcu * NWAVES + F.wave, NGW = F.G * NWAVES;
    constexpr int I_IN = (D / 64) * (NIN / 32), I_OUT = (D / 64) * (D / 32), I_GU = (D / 64) * (NGU / 32), I_DN = (DFF / 64) * (D / 32);
    constexpr int NITEMS = I_IN + I_OUT + I_GU + I_DN;
    bf16* WIN = (bf16*)(ws + WS_WIN); bf16* WOUT = (bf16*)(ws + WS_WOUT); bf16* WGU = (bf16*)(ws + WS_WGU); bf16* WDN = (bf16*)(ws + WS_WDN);
    for (int it = gw; it < NITEMS; it += NGW) {
        int r = it;
        if (r < I_IN) { const int nblk = NIN / 32, kb = r / nblk, nb = r % nblk;
            transpose_item(L.w_in, D, IN_REAL, WIN, scr, kb, nb, F.lane, [](int d) { return d < 6144 ? d : (d < 11520 ? d + 16 : (d < 11536 ? d - 11520 + 6144 : -1)); }); continue; }
        r -= I_IN;
        if (r < I_OUT) { const int nblk = D / 32, kb = r / nblk, nb = r % nblk;
            transpose_item(L.w_out, D, D, WOUT, scr, kb, nb, F.lane, [](int d) { return d; }); continue; }
        r -= I_OUT;
        if (r < I_GU) { const int nblk = NGU / 32, kb = r / nblk, nb = r % nblk; const int row0 = nb * 32; const bool up = (row0 & 255) >= 128;
            transpose_item(up ? L.w_up : L.w_gate, D, DFF, WGU, scr, kb, nb, F.lane, [](int d) { return (d >> 8) * 128 + (d & 127); }); continue; }
        r -= I_GU;
        { const int nblk = D / 32, kb = r / nblk, nb = r % nblk;
            transpose_item(L.w_down, DFF, D, WDN, scr, kb, nb, F.lane, [](int d) { return d; }); }
    }
}

__device__ __forceinline__ void phase_rmsnorm(Frame& F, const float* X, const float* gain, bf16* O, float* RSTD) {
    const int gw = F.vcu * NWAVES + F.wave, NGW = F.G * NWAVES;
    for (int m = gw; m < M; m += NGW) {
        const GAS f32x4* xr = (const GAS f32x4*)(X + (size_t)m * D) + F.lane;
        f32x4 v[16]; float s = 0.f;
#pragma unroll
        for (int j = 0; j < 16; ++j) { v[j] = xr[64 * j]; s += (v[j].x * v[j].x + v[j].y * v[j].y) + (v[j].z * v[j].z + v[j].w * v[j].w); }
        const float rstd = 1.0f / sqrtf(wave_sum(s) * (1.0f / D) + EPS);
        GAS unsigned long long* o8 = (GAS unsigned long long*)(O + (size_t)m * D) + F.lane;
        const GAS f32x4* gr = (const GAS f32x4*)gain + F.lane;
#pragma unroll
        for (int j = 0; j < 16; ++j) { const f32x4 g = gr[64 * j];
            o8[64 * j] = (unsigned long long)pk2(v[j].x * g.x, v[j].y * g.y) | ((unsigned long long)pk2(v[j].z * g.z, v[j].w * g.w) << 32); }
        if (F.lane == 0) RSTD[m] = rstd;
    }
}


__device__ __forceinline__ void phase_rstd(Frame& F, const float* RS, float* RSTD) {
    for (int m = blockIdx.x * (NWAVES * 64) + F.tid; m < M; m += F.G * NWAVES * 64) {
        const GAS f32x4* p = (const GAS f32x4*)(RS + (size_t)m * 64); float s = 0.f;
#pragma unroll
        for (int j = 0; j < 16; ++j) { const f32x4 v = p[j]; s += (v.x + v.y) + (v.z + v.w); }
        RSTD[m] = 1.0f / sqrtf(s * (1.0f / D) + EPS);
    }
}
__device__ __forceinline__ void unpack8(const v4u& w, float (&x)[8]) { x[0] = bf_lo(w.x); x[1] = bf_hi(w.x); x[2] = bf_lo(w.y); x[3] = bf_hi(w.y); x[4] = bf_lo(w.z); x[5] = bf_hi(w.z); x[6] = bf_lo(w.w); x[7] = bf_hi(w.w); }
__device__ __forceinline__ v4u gld16p(const void* base, unsigned off) { return *(const GAS v4u*)((const GAS char*)base + off); }
__device__ __forceinline__ void gst16p(void* base, unsigned off, v4u v) { *(GAS v4u*)((GAS char*)base + off) = v; }
__device__ __forceinline__ float sumsq8(const v4u& w) { float x[8]; unpack8(w, x); return (x[0] * x[0] + x[1] * x[1]) + (x[2] * x[2] + x[3] * x[3]) + (x[4] * x[4] + x[5] * x[5]) + (x[6] * x[6] + x[7] * x[7]); }
__device__ __forceinline__ v4u scale8(const v4u& w, float r, const LAS float* gain) { float x[8]; unpack8(w, x); const f32x4 ga = *(const LAS f32x4*)gain, gb = *(const LAS f32x4*)(gain + 4);
    v4u o; o.x = pk2(x[0] * r * ga.x, x[1] * r * ga.y); o.y = pk2(x[2] * r * ga.z, x[3] * r * ga.w); o.z = pk2(x[4] * r * gb.x, x[5] * r * gb.y); o.w = pk2(x[6] * r * gb.z, x[7] * r * gb.w); return o; }

__device__ __forceinline__ float row16p(float v) {
    v += __builtin_bit_cast(float, __builtin_amdgcn_update_dpp(0, __builtin_bit_cast(int, v), 0xB1, 0xF, 0xF, true));
    v += __builtin_bit_cast(float, __builtin_amdgcn_update_dpp(0, __builtin_bit_cast(int, v), 0x4E, 0xF, 0xF, true));
    v += __builtin_bit_cast(float, __builtin_amdgcn_update_dpp(0, __builtin_bit_cast(int, v), 0x141, 0xF, 0xF, true));
    v += __builtin_bit_cast(float, __builtin_amdgcn_update_dpp(0, __builtin_bit_cast(int, v), 0x140, 0xF, 0xF, true));
    return v;
}
constexpr int PM_PART = 0, PM_TL = 4096, PM_TL2 = PM_TL + 128 * 528, PM_GAIN = PM_TL2 + 64 * 528, PM_END = PM_GAIN + 1024;
static_assert(PM_END <= RING_BYTES && 256 * 272 <= 128 * 528 + 64 * 528, "moba prep LDS map (the K tile may run into TL2: it is dead before TL2 is written)");
__device__ __forceinline__ void phase_prep_moba(Frame& F, const LayerW& L, unsigned char* ws) {
    const bf16* PROJ = (const bf16*)(ws + WS_PROJ); bf16* QN = (bf16*)(ws + WS_QN); bf16* KN = (bf16*)(ws + WS_KN); float* KMEAN = (float*)(ws + WS_KMEAN);
    bf16* VTG = (bf16*)(ws + WS_VTG); bf16* SVT = (bf16*)(ws + WS_SVT);
    LAS unsigned char* LB = F.lds + RING_OFF;
    LAS float* part = (LAS float*)(LB + PM_PART);
    LAS unsigned char* TL = LB + PM_TL; LAS unsigned char* TL2 = LB + PM_TL2;
    LAS float* gain = (LAS float*)(LB + PM_GAIN);
    if (F.tid < 128) gain[F.tid] = L.moba_qn[F.tid]; else if (F.tid < 256) gain[F.tid] = L.moba_kn[F.tid - 128];
    __syncthreads();
    for (int u = blockIdx.x; u < BATCH * MOBA_NB * NHEAD; u += F.G) {
        int tid = F.tid; asm volatile("" : "+v"(tid));
        const int lane = tid & 63, wv = tid >> 6;
        const int h = u % NHEAD, n = (u / NHEAD) % MOBA_NB, b = u / (NHEAD * MOBA_NB);
        const size_t mb = (size_t)b * SEQ + (size_t)n * MOBA_BLK;
        const bf16* pbase = PROJ + mb * NIN + h * HD;
        const int c16 = lane & 15, tq = lane >> 4, tk0 = 32 * wv + tq;
        const unsigned loff = (unsigned)((tk0 * NIN + 8 * c16) * 2);
        v4u qv[8], kv[8], vv[8];
#pragma unroll
        for (int i = 0; i < 8; ++i) { const unsigned o = loff + (unsigned)(4 * i * NIN * 2); qv[i] = gld16p(pbase + PC_MQ, o); kv[i] = gld16p(pbase + PC_MK, o); vv[i] = gld16p(pbase + PC_MV, o); }
        v4u sv[4];
        const int c8 = lane & 7, t8 = lane >> 3;
        if (h < 2) {
#pragma unroll
            for (int i = 0; i < 4; ++i) sv[i] = gld16p(PROJ + mb * NIN + PC_SV + h * 64, (unsigned)(((32 * wv + 8 * i + t8) * NIN + 8 * c8) * 2));
        }
        const unsigned ooff = (unsigned)((tk0 * GWID + 8 * c16) * 2);
#pragma unroll
        for (int i = 0; i < 8; ++i) {
            const float sq = row16p(sumsq8(qv[i])), sk = row16p(sumsq8(kv[i]));
            const float rq = 1.0f / sqrtf(sq * (1.0f / HD) + EPS), rk = 1.0f / sqrtf(sk * (1.0f / HD) + EPS);
            const unsigned o = ooff + (unsigned)(4 * i * GWID * 2);
            gst16p(QN + mb * GWID + h * HD, o, scale8(qv[i], rq, gain + 8 * c16));
            const v4u kn = scale8(kv[i], rk, gain + 128 + 8 * c16);
            gst16p(KN + mb * GWID + h * HD, o, kn);
            *(LAS v4u*)(TL + (tk0 + 4 * i) * 272 + 16 * c16) = kn;
        }
        __syncthreads();
        {
            const int ch = tid & 127, qr = tid >> 7; float s = 0.f;
#pragma unroll 8
            for (int t = 0; t < 64; ++t) s += bf1(*(const LAS unsigned short*)(TL + (64 * qr + t) * 272 + ch * 2));
            part[qr * 128 + ch] = s;
        }
        __syncthreads();
        if (tid < 128) KMEAN[((size_t)(b * NHEAD + h) * MOBA_NB + n) * HD + tid] = ((part[tid] + part[128 + tid]) + (part[256 + tid] + part[384 + tid])) * (1.0f / MOBA_BLK);
#pragma unroll
        for (int i = 0; i < 8; ++i) { const unsigned w4[4] = {vv[i].x, vv[i].y, vv[i].z, vv[i].w}; const int tk = tk0 + 4 * i;
            LAS unsigned char* col = TL + (((tk >> 3) ^ c16) * 16) + (tk & 7) * 2;
#pragma unroll
            for (int e = 0; e < 4; ++e) { const int d = 8 * c16 + 2 * e;
                *(LAS unsigned short*)(col + d * 528) = (unsigned short)(w4[e] & 0xffffu); *(LAS unsigned short*)(col + (d + 1) * 528) = (unsigned short)(w4[e] >> 16); } }
        if (h < 2) {
#pragma unroll
            for (int i = 0; i < 4; ++i) { const unsigned w4[4] = {sv[i].x, sv[i].y, sv[i].z, sv[i].w}; const int tk = 32 * wv + 8 * i + t8;
                LAS unsigned char* col = TL2 + (((tk >> 3) ^ c8) * 16) + (tk & 7) * 2;
#pragma unroll
                for (int e = 0; e < 4; ++e) { const int d = 8 * c8 + 2 * e;
                    *(LAS unsigned short*)(col + d * 528) = (unsigned short)(w4[e] & 0xffffu); *(LAS unsigned short*)(col + (d + 1) * 528) = (unsigned short)(w4[e] >> 16); } }
        }
        __syncthreads();
        { const int row = tid >> 2, qq = tid & 3;
          bf16* dst = VTG + ((size_t)(b * NHEAD + h) * HD + row) * SEQ + n * MOBA_BLK + qq * 64;
#pragma unroll
          for (int j = 0; j < 8; ++j) *(GAS v4u*)(dst + 8 * j) = *(const LAS v4u*)(TL + row * 528 + (((qq * 8 + j) ^ ((row >> 3) & 15)) * 16));
          if (h < 2 && tid < 256) { bf16* dst2 = SVT + ((size_t)(b * 2 + h) * 64 + row) * SEQ + n * MOBA_BLK + qq * 64;
#pragma unroll
              for (int j = 0; j < 8; ++j) *(GAS v4u*)(dst2 + 8 * j) = *(const LAS v4u*)(TL2 + row * 528 + (((qq * 8 + j) ^ ((row >> 3) & 7)) * 16)); } }
        __syncthreads();
    }
}

constexpr int PT_SCW = 0, PT_GQ = 12288, PT_GK = PT_GQ + 256;
__device__ __forceinline__ void phase_prep_tokens(Frame& F, const LayerW& L, unsigned char* ws) {
    const bf16* PROJ = (const bf16*)(ws + WS_PROJ); bf16* SQN = (bf16*)(ws + WS_SQN); bf16* SKN = (bf16*)(ws + WS_SKN); bf16* MIX = (bf16*)(ws + WS_MIX);
    LAS unsigned char* LB = F.lds + RING_OFF;
    LAS float* scw = (LAS float*)(LB + PT_SCW); LAS float* gq = (LAS float*)(LB + PT_GQ); LAS float* gk = (LAS float*)(LB + PT_GK);
    for (int i = F.tid; i < 3 * GWID; i += NWAVES * 64) scw[i] = L.sc_conv[i];
    if (F.tid < 64) gq[F.tid] = L.swa_qn[F.tid]; else if (F.tid < 128) gk[F.tid - 64] = L.swa_kn[F.tid - 64];
    __syncthreads();
    const int gw = F.vcu * NWAVES + F.wave, NGW = F.G * NWAVES;
    int lane = F.lane; asm volatile("" : "+v"(lane));
    const unsigned lo16 = (unsigned)lane * 16u;
    for (int m0 = 2 * gw; m0 < M; m0 += 2 * NGW) {
        v4u q0[2][2], kx[2], cc[2][3][2], cx[2][3][2], cb[2][2];
#pragma unroll
        for (int t = 0; t < 2; ++t) {
            const int m = m0 + t, s = m % SEQ;
            const GAS char* row = (const GAS char*)(PROJ + (size_t)m * NIN);
            q0[t][0] = *(const GAS v4u*)(row + PC_SQ * 2 + lo16); q0[t][1] = *(const GAS v4u*)(row + PC_SQ * 2 + 1024 + lo16);
            kx[t] = (lane < 16) ? *(const GAS v4u*)(row + PC_SK * 2 + lo16) : (v4u){0u, 0u, 0u, 0u};
#pragma unroll
            for (int i = 0; i < 3; ++i) {
                const bool ok = (s - 2 + i) >= 0;
                const GAS char* rw = row - (size_t)(2 - i) * (NIN * 2);
#pragma unroll
                for (int hf = 0; hf < 2; ++hf) {
                    cc[t][i][hf] = ok ? *(const GAS v4u*)(rw + PC_SCC * 2 + 1024 * hf + lo16) : (v4u){0u, 0u, 0u, 0u};
                    cx[t][i][hf] = ok ? *(const GAS v4u*)(rw + PC_SCX * 2 + 1024 * hf + lo16) : (v4u){0u, 0u, 0u, 0u}; }
            }
            cb[t][0] = *(const GAS v4u*)(row + PC_SCB * 2 + lo16); cb[t][1] = *(const GAS v4u*)(row + PC_SCB * 2 + 1024 + lo16);
        }
#pragma unroll
        for (int t = 0; t < 2; ++t) {
            const int m = m0 + t;
#pragma unroll
            for (int hf = 0; hf < 2; ++hf) {
                float ss = sumsq8(q0[t][hf]); ss += __shfl_xor(ss, 1); ss += __shfl_xor(ss, 2); ss += __shfl_xor(ss, 4);
                const float r = __builtin_amdgcn_rsqf(ss * (1.0f / 64.0f) + EPS);
                *(GAS v4u*)((GAS char*)(SQN + (size_t)m * GWID) + 1024 * hf + lo16) = scale8(q0[t][hf], r, gq + 8 * (lane & 7));
            }
            { float ss = sumsq8(kx[t]); ss += __shfl_xor(ss, 1); ss += __shfl_xor(ss, 2); ss += __shfl_xor(ss, 4);
              const float r = __builtin_amdgcn_rsqf(ss * (1.0f / 64.0f) + EPS);
              if (lane < 16) *(GAS v4u*)((GAS char*)(SKN + (size_t)m * 128) + lo16) = scale8(kx[t], r, gk + 8 * (lane & 7)); }
#pragma unroll
            for (int hf = 0; hf < 2; ++hf) {
                float acc[8] = {0.f, 0.f, 0.f, 0.f, 0.f, 0.f, 0.f, 0.f};
#pragma unroll
                for (int i = 0; i < 3; ++i) { float a[8], b[8]; unpack8(cc[t][i][hf], a); unpack8(cx[t][i][hf], b);
                    const LAS float* wp = scw + i * GWID + 512 * hf + 8 * lane; const f32x4 wa = *(const LAS f32x4*)wp, wb = *(const LAS f32x4*)(wp + 4);
                    acc[0] += a[0] * b[0] * wa.x; acc[1] += a[1] * b[1] * wa.y; acc[2] += a[2] * b[2] * wa.z; acc[3] += a[3] * b[3] * wa.w;
                    acc[4] += a[4] * b[4] * wb.x; acc[5] += a[5] * b[5] * wb.y; acc[6] += a[6] * b[6] * wb.z; acc[7] += a[7] * b[7] * wb.w; }
                float bx[8]; unpack8(cb[t][hf], bx);
                v4u o; o.x = pk2(bx[0] * acc[0], bx[1] * acc[1]); o.y = pk2(bx[2] * acc[2], bx[3] * acc[3]); o.z = pk2(bx[4] * acc[4], bx[5] * acc[5]); o.w = pk2(bx[6] * acc[6], bx[7] * acc[7]);
                *(GAS v4u*)((GAS char*)(MIX + (size_t)m * D + MC_C) + 1024 * hf + lo16) = o;
            }
        }
    }
}
constexpr int GDN_C = 64, GDN_NCH = SEQ / GDN_C, GDN_NCHUNKS = BATCH * NHEAD * GDN_NCH;
constexpr size_t WS_CH = 1272 * MiB, WS_GL = 1416 * MiB, WS_END2 = 1417 * MiB;
constexpr int CH_BYTES = 73728, CH_WF = 0, CH_QD = 16384, CH_KD = 32768, CH_QK = 49152, CH_UF = 57344, CH_LDS = 57344;
static_assert(WS_CH + (size_t)GDN_NCHUNKS * CH_BYTES <= WS_GL && 2 * CH_LDS + 4096 <= RING_BYTES, "chunk records");
constexpr int PL_KR = 0, PL_QR = 17408, PL_KT = 34816, PL_VT = 53248, PL_AT = 71680, PL_T1 = 89088, PL_T2 = 98304, PL_VEC = 107520, PL_CW = 108544;
constexpr int P_RM = 272, P_TR = 144, P_AT = 68;
static_assert(PL_AT + 64 * P_AT * 4 <= PL_T1 && PL_CW + 6144 <= RING_BYTES, "prep LDS map");
typedef unsigned v2u __attribute__((ext_vector_type(2)));

__device__ __forceinline__ bf16x8 ldsfrag(const LAS unsigned char* base, int pitch, int row, int k0) { return *(const LAS bf16x8*)(base + row * pitch + k0 * 2); }
__device__ __forceinline__ v4u pack8f(const float (&x)[8]) { v4u o; o.x = pk2c(x[0], x[1]); o.y = pk2c(x[2], x[3]); o.z = pk2c(x[4], x[5]); o.w = pk2c(x[6], x[7]); return o; }
#define MFMA16(a, b, c) __builtin_amdgcn_mfma_f32_16x16x32_bf16((a), (b), (c), 0, 0, 0)

__device__ __forceinline__ void phase_gdn_chunk_prep(Frame& F, unsigned char* ws, const float* conv_w, const float* alog, const float* dtb) {
    const bf16* PROJ = (const bf16*)(ws + WS_PROJ);
    LAS unsigned char* L = F.lds + RING_OFF;
    LAS float* vG = (LAS float*)(L + PL_VEC); LAS float* vEG = vG + 64; LAS float* vEGL = vG + 128; LAS float* vB = vG + 192;
    LAS float* At = (LAS float*)(L + PL_AT);
    LAS float* cwl = (LAS float*)(L + PL_CW);
    const float scale = 0.08838834764831845f;
    int hstaged = -1;
#define CP_LOAD(ci_, X_) do { const int bh_ = (ci_) / GDN_NCH, n_ = (ci_) % GDN_NCH; const size_t m0_ = (size_t)(bh_ / NHEAD) * SEQ + (size_t)n_ * GDN_C; \
        int t2_ = F.tid; asm volatile("" : "+v"(t2_)); const int tok_ = t2_ >> 3, sub_ = t2_ & 7, spos_ = n_ * GDN_C + tok_; \
        const GAS char* pb_ = (const GAS char*)PROJ + ((long long)m0_ - 3) * (NIN * 2) + (PC_GQ + (bh_ % NHEAD) * HD + 16 * sub_) * 2; \
        _Pragma("unroll") for (int mat_ = 0; mat_ < 3; ++mat_) _Pragma("unroll") for (int i_ = 0; i_ < 4; ++i_) { \
            if (spos_ - 3 + i_ >= 0) { const unsigned ro_ = (unsigned)((tok_ + i_) * NIN * 2 + mat_ * GWID * 2); X_[mat_][i_][0] = *(const GAS v4u*)(pb_ + ro_); X_[mat_][i_][1] = *(const GAS v4u*)(pb_ + ro_ + 16); } \
            else { X_[mat_][i_][0] = (v4u){0u, 0u, 0u, 0u}; X_[mat_][i_][1] = (v4u){0u, 0u, 0u, 0u}; } } \
        if (F.wave == 0) { const bf16* pr_ = PROJ + (m0_ + (t2_ & 63)) * NIN + (bh_ % NHEAD); gaw = pr_[PC_GA]; gbw = pr_[PC_GB]; } } while (0)
    const int cper = (GDN_NCHUNKS + F.G - 1) / F.G;
    v4u xr[3][4][2]; bf16 gaw = 0, gbw = 0;
    { const int c0 = blockIdx.x * cper; if (c0 < GDN_NCHUNKS) CP_LOAD(c0, xr); }
    for (int ci = blockIdx.x * cper; ci < GDN_NCHUNKS && ci < (int)(blockIdx.x + 1) * cper; ++ci) {
        int tid = F.tid; asm volatile("" : "+v"(tid));
        const int lane = tid & 63, wv = F.wave, c = lane & 15, g = lane >> 4;
        const int bh = ci / GDN_NCH, n = ci % GDN_NCH, b = bh / NHEAD, h = bh % NHEAD;
        const size_t m0 = (size_t)b * SEQ + (size_t)n * GDN_C;
        if (h != hstaged) {
            __syncthreads();
            for (int i = tid; i < 3 * 4 * 128; i += NWAVES * 64) { const int mat = i / 512, tap = (i / 128) & 3, ch = i & 127; cwl[i] = conv_w[tap * 3 * GWID + mat * GWID + h * HD + ch]; }
            hstaged = h;
            __syncthreads();
        }
        {
            const int tok = tid >> 3, sub = tid & 7, spos = n * GDN_C + tok;
            const GAS char* pback = (const GAS char*)PROJ + ((long long)m0 - 3) * (NIN * 2) + (PC_GQ + h * HD + 16 * sub) * 2;
#pragma unroll
            for (int mat = 0; mat < 3; ++mat) {
                float acc[16];
#pragma unroll
                for (int e = 0; e < 16; ++e) acc[e] = 0.f;
#pragma unroll
                for (int i = 0; i < 4; ++i)
#pragma unroll
                    for (int hf = 0; hf < 2; ++hf) { float x[8]; unpack8(xr[mat][i][hf], x);
                        const LAS float* wp = cwl + (mat * 4 + i) * 128 + 16 * sub + 8 * hf; const f32x4 wa = *(const LAS f32x4*)wp, wb = *(const LAS f32x4*)(wp + 4);
                        acc[8 * hf + 0] += x[0] * wa.x; acc[8 * hf + 1] += x[1] * wa.y; acc[8 * hf + 2] += x[2] * wa.z; acc[8 * hf + 3] += x[3] * wa.w;
                        acc[8 * hf + 4] += x[4] * wb.x; acc[8 * hf + 5] += x[5] * wb.y; acc[8 * hf + 6] += x[6] * wb.z; acc[8 * hf + 7] += x[7] * wb.w; }
                float ss = 0.f;
#pragma unroll
                for (int e = 0; e < 16; ++e) { acc[e] = acc[e] * __builtin_amdgcn_rcpf(1.0f + __expf(-acc[e])); ss += acc[e] * acc[e]; }
                if (mat < 2) { ss += __shfl_xor(ss, 1); ss += __shfl_xor(ss, 2); ss += __shfl_xor(ss, 4);
                    const float r = __builtin_amdgcn_rsqf(ss + EPS);
#pragma unroll
                    for (int e = 0; e < 16; ++e) acc[e] *= r; }
                unsigned pw[8];
#pragma unroll
                for (int e = 0; e < 8; ++e) pw[e] = pk2c(acc[2 * e], acc[2 * e + 1]);
                if (mat < 2) { LAS unsigned char* img = L + (mat == 0 ? PL_QR : PL_KR) + tok * P_RM + sub * 32;
                    *(LAS v4u*)img = (v4u){pw[0], pw[1], pw[2], pw[3]}; *(LAS v4u*)(img + 16) = (v4u){pw[4], pw[5], pw[6], pw[7]}; }
                if (mat >= 1) { LAS unsigned char* timg = L + (mat == 1 ? PL_KT : PL_VT) + (16 * sub) * P_TR + tok * 2;
#pragma unroll
                    for (int e = 0; e < 8; ++e) { *(LAS unsigned short*)(timg + (2 * e) * P_TR) = (unsigned short)(pw[e] & 0xffffu); *(LAS unsigned short*)(timg + (2 * e + 1) * P_TR) = (unsigned short)(pw[e] >> 16); } }
            }
        }
        if (wv == 0) {
            const float ga = bf1(gaw), gb = bf1(gbw);
            const float xx = ga + dtb[h];
            const float sp = xx > 20.0f ? xx : log1pf(expf(xx));
            float x = -expf(alog[h]) * sp;
#pragma unroll
            for (int o = 1; o < 64; o <<= 1) { const float y = __shfl_up(x, o); if (lane >= o) x += y; }
            const float glast = __shfl(x, 63);
            vG[lane] = x; vEG[lane] = __expf(x); vEGL[lane] = __expf(glast - x); vB[lane] = 1.0f / (1.0f + expf(-gb));
            if (lane == 63) ((float*)(ws + WS_GL))[ci] = __expf(x);
        }
        __syncthreads();
        if (ci + 1 < GDN_NCHUNKS && ci + 1 < (int)(blockIdx.x + 1) * cper) CP_LOAD(ci + 1, xr);
        if (wv < 4) {
            const int it = wv;
            bf16x8 fa[4], fb[4][4];
#pragma unroll
            for (int s = 0; s < 4; ++s) fa[s] = ldsfrag(L + PL_KR, P_RM, 16 * it + c, 32 * s + 8 * g);
#pragma unroll
            for (int jt = 0; jt < 4; ++jt)
#pragma unroll
                for (int s = 0; s < 4; ++s) fb[jt][s] = ldsfrag(L + PL_KR, P_RM, 16 * jt + c, 32 * s + 8 * g);
            asm volatile("s_waitcnt lgkmcnt(0)" ::: "memory"); __builtin_amdgcn_sched_barrier(0);
#pragma unroll
            for (int jt = 0; jt < 4; ++jt) {
                f32x4 acc = {0.f, 0.f, 0.f, 0.f};
#pragma unroll
                for (int s = 0; s < 4; ++s) acc = MFMA16(fa[s], fb[jt][s], acc);
                const int j = 16 * jt + c; const float Gj = vG[j];
#pragma unroll
                for (int r = 0; r < 4; ++r) { const int i = 16 * it + 4 * g + r;
                    At[j * P_AT + i] = (i > j) ? vB[i] * acc[r] * __expf(vG[i] - Gj) : 0.0f; }
            }
        } else {
            const int sp = (wv - 4) >> 1, half = (wv - 4) & 1;
            bf16x8 fk[2][4], fq[2][4];
#pragma unroll
            for (int x = 0; x < 2; ++x)
#pragma unroll
                for (int s = 0; s < 4; ++s) { fk[x][s] = ldsfrag(L + PL_KR, P_RM, 16 * (2 * sp + x) + c, 32 * s + 8 * g); fq[x][s] = ldsfrag(L + PL_QR, P_RM, 16 * (2 * half + x) + c, 32 * s + 8 * g); }
            asm volatile("s_waitcnt lgkmcnt(0)" ::: "memory"); __builtin_amdgcn_sched_barrier(0);
#pragma unroll
            for (int ii = 0; ii < 2; ++ii) {
                const int itp = 2 * half + ii; float out[8];
                const int i = 16 * itp + c; const float Gi = vG[i];
#pragma unroll
                for (int jj = 0; jj < 2; ++jj) {
                    const int jt = 2 * sp + jj;
                    f32x4 acc = {0.f, 0.f, 0.f, 0.f};
#pragma unroll
                    for (int s = 0; s < 4; ++s) acc = MFMA16(fk[jj][s], fq[ii][s], acc);
#pragma unroll
                    for (int r = 0; r < 4; ++r) { const int j = 16 * jt + 4 * g + r; out[4 * jj + r] = (i >= j) ? scale * acc[r] * __expf(Gi - vG[j]) : 0.0f; }
                }
                *(GAS v4u*)(ws + WS_CH + (size_t)ci * CH_BYTES + CH_QK + ((itp * 2 + sp) * 64 + lane) * 16) = pack8f(out);
            }
        }
        __syncthreads();
        constexpr int PD = 20;
        LAS float* Drow = (LAS float*)(L + PL_KR); LAS float* Dcol = Drow + 64 * PD;
        if (wv == 0) {
            float col[16];
#pragma unroll
            for (int i = 0; i < 16; ++i) col[i] = (i == c) ? 1.0f : 0.0f;
            const LAS float* Ad = At + (16 * g) * (P_AT + 1);
#pragma unroll
            for (int j = 0; j < 15; ++j) {
                f32x4 a[4];
#pragma unroll
                for (int q = (j + 1) >> 2; q < 4; ++q) a[q] = *(const LAS f32x4*)(Ad + j * P_AT + 4 * q);
                __builtin_amdgcn_sched_barrier(0);
                const float cj = col[j];
#pragma unroll
                for (int i = j + 1; i < 16; ++i) col[i] -= a[i >> 2][i & 3] * cj;
                __builtin_amdgcn_sched_barrier(0);
            }
#pragma unroll
            for (int q = 0; q < 4; ++q) *(LAS f32x4*)(Dcol + lane * PD + 4 * q) = (f32x4){col[4 * q], col[4 * q + 1], col[4 * q + 2], col[4 * q + 3]};
            const float b1 = vB[lane], b2 = b1 * vEG[lane];
#pragma unroll
            for (int i = 0; i < 16; ++i) {
                Drow[(16 * g + i) * PD + c] = col[i];
                *(LAS unsigned short*)(L + PL_T1 + (16 * g + i) * P_TR + lane * 2) = (unsigned short)f2bf(col[i] * b1);
                *(LAS unsigned short*)(L + PL_T2 + (16 * g + i) * P_TR + lane * 2) = (unsigned short)f2bf(col[i] * b2);
            }
        } else {
            for (int f = wv - 1; f < 32; f += 7) {
                float x[8];
                if (f < 16) {
                    const int tt = f >> 2, s = f & 3, tok = 16 * tt + c;
                    const v2u lo = *(const LAS v2u*)(L + PL_QR + tok * P_RM + (32 * s + 4 * g) * 2), hi = *(const LAS v2u*)(L + PL_QR + tok * P_RM + (32 * s + 16 + 4 * g) * 2);
                    const float fs = scale * vEG[tok];
                    x[0] = bf_lo(lo.x) * fs; x[1] = bf_hi(lo.x) * fs; x[2] = bf_lo(lo.y) * fs; x[3] = bf_hi(lo.y) * fs;
                    x[4] = bf_lo(hi.x) * fs; x[5] = bf_hi(hi.x) * fs; x[6] = bf_lo(hi.y) * fs; x[7] = bf_hi(hi.y) * fs;
                    *(GAS v4u*)(ws + WS_CH + (size_t)ci * CH_BYTES + CH_QD + (f * 64 + lane) * 16) = pack8f(x);
                } else {
                    const int ff = f - 16, dt = ff >> 1, sp = ff & 1, dk = 16 * dt + c;
                    const v2u lo = *(const LAS v2u*)(L + PL_KT + dk * P_TR + (32 * sp + 4 * g) * 2), hi = *(const LAS v2u*)(L + PL_KT + dk * P_TR + (32 * sp + 16 + 4 * g) * 2);
                    const f32x4 e0 = *(const LAS f32x4*)(vEGL + 32 * sp + 4 * g), e1 = *(const LAS f32x4*)(vEGL + 32 * sp + 16 + 4 * g);
                    x[0] = bf_lo(lo.x) * e0.x; x[1] = bf_hi(lo.x) * e0.y; x[2] = bf_lo(lo.y) * e0.z; x[3] = bf_hi(lo.y) * e0.w;
                    x[4] = bf_lo(hi.x) * e1.x; x[5] = bf_hi(hi.x) * e1.y; x[6] = bf_lo(hi.y) * e1.z; x[7] = bf_hi(hi.y) * e1.w;
                    *(GAS v4u*)(ws + WS_CH + (size_t)ci * CH_BYTES + CH_KD + (ff * 64 + lane) * 16) = pack8f(x);
                }
            }
        }
        __syncthreads();
#define INV_CHAIN(B) do { \
            f32x4 T_[4]; T_[B] = *(const LAS f32x4*)(Dcol + (16 * (B) + c) * PD + 4 * g); \
            const float b1c = vB[16 * (B) + c], b2c = b1c * vEG[16 * (B) + c]; \
            _Pragma("unroll") for (int a_ = (B) + 1; a_ < 4; ++a_) { \
                f32x4 Y_ = {0.f, 0.f, 0.f, 0.f}; \
                _Pragma("unroll") for (int m_ = (B); m_ < a_; ++m_) \
                    _Pragma("unroll") for (int kk = 0; kk < 4; ++kk) Y_ = __builtin_amdgcn_mfma_f32_16x16x4f32(At[(16 * m_ + 4 * g + kk) * P_AT + 16 * a_ + c], T_[m_][kk], Y_, 0, 0, 0); \
                const f32x4 da_ = *(const LAS f32x4*)(Drow + (16 * a_ + c) * PD + 4 * g); \
                f32x4 Z_ = {0.f, 0.f, 0.f, 0.f}; \
                _Pragma("unroll") for (int kk = 0; kk < 4; ++kk) Z_ = __builtin_amdgcn_mfma_f32_16x16x4f32(da_[kk], Y_[kk], Z_, 0, 0, 0); \
                T_[a_] = -Z_; \
                _Pragma("unroll") for (int r = 0; r < 4; ++r) { \
                    *(LAS unsigned short*)(L + PL_T1 + (16 * a_ + 4 * g + r) * P_TR + (16 * (B) + c) * 2) = (unsigned short)f2bf(T_[a_][r] * b1c); \
                    *(LAS unsigned short*)(L + PL_T2 + (16 * a_ + 4 * g + r) * P_TR + (16 * (B) + c) * 2) = (unsigned short)f2bf(T_[a_][r] * b2c); } } } while (0)
        if (wv == 0) INV_CHAIN(0); else if (wv == 1) INV_CHAIN(1); else if (wv == 2) INV_CHAIN(2);
        else if (wv == 3) {
#pragma unroll
            for (int it = 0; it < 6; ++it) { const int item = lane + 64 * it, img = item / 192, rest = item % 192, blk = rest >> 5, row = (rest & 31) >> 1, hf = rest & 1;
                const int ba = blk < 3 ? 0 : (blk < 5 ? 1 : 2), bb = blk < 3 ? blk + 1 : (blk < 5 ? blk - 1 : 3);
                *(LAS v4u*)(L + (img ? PL_T2 : PL_T1) + (16 * ba + row) * P_TR + 32 * bb + 16 * hf) = (v4u){0u, 0u, 0u, 0u}; }
        }
#undef INV_CHAIN
        __syncthreads();
        float vone = 1.0f; asm volatile("" : "+v"(vone));
        if (wv < 4) {
            const int it = wv;
            bf16x8 ft[2], fv[8][2];
#pragma unroll
            for (int sp = 0; sp < 2; ++sp) ft[sp] = ldsfrag(L + PL_T1, P_TR, 16 * it + c, 32 * sp + 8 * g);
#pragma unroll
            for (int dvt = 0; dvt < 8; ++dvt)
#pragma unroll
                for (int sp = 0; sp < 2; ++sp) fv[dvt][sp] = ldsfrag(L + PL_VT, P_TR, 16 * dvt + c, 32 * sp + 8 * g);
            asm volatile("s_waitcnt lgkmcnt(0)" ::: "memory"); __builtin_amdgcn_sched_barrier(0);
#pragma unroll
            for (int dvt = 0; dvt < 8; ++dvt) {
                f32x4 acc = {0.f, 0.f, 0.f, 0.f};
#pragma unroll
                for (int sp = 0; sp < 2; ++sp) acc = MFMA16(ft[sp], fv[dvt][sp], acc);
                acc = acc * vone;
                v2u o; o.x = pk2c(acc[0], acc[1]); o.y = pk2c(acc[2], acc[3]);
                *(GAS v2u*)(ws + WS_CH + (size_t)ci * CH_BYTES + CH_UF + ((dvt * 4 + it) * 64 + lane) * 8) = o;
            }
        } else {
            const int it = wv - 4;
            bf16x8 ft2[2], fkt[8][2];
#pragma unroll
            for (int sp = 0; sp < 2; ++sp) ft2[sp] = ldsfrag(L + PL_T2, P_TR, 16 * it + c, 32 * sp + 8 * g);
#pragma unroll
            for (int dkt = 0; dkt < 8; ++dkt)
#pragma unroll
                for (int sp = 0; sp < 2; ++sp) fkt[dkt][sp] = ldsfrag(L + PL_KT, P_TR, 16 * dkt + c, 32 * sp + 8 * g);
            asm volatile("s_waitcnt lgkmcnt(0)" ::: "memory"); __builtin_amdgcn_sched_barrier(0);
#pragma unroll
            for (int s = 0; s < 4; ++s) {
                float x[8];
#pragma unroll
                for (int dd = 0; dd < 2; ++dd) {
                    const int dkt = 2 * s + dd;
                    f32x4 acc = {0.f, 0.f, 0.f, 0.f};
#pragma unroll
                    for (int sp = 0; sp < 2; ++sp) acc = MFMA16(fkt[dkt][sp], ft2[sp], acc);
                    x[4 * dd] = acc[0] * vone; x[4 * dd + 1] = acc[1] * vone; x[4 * dd + 2] = acc[2] * vone; x[4 * dd + 3] = acc[3] * vone;
                }
                *(GAS v4u*)(ws + WS_CH + (size_t)ci * CH_BYTES + CH_WF + ((it * 4 + s) * 64 + lane) * 16) = pack8f(x);
            }
        }
        __syncthreads();
    }
}

__device__ __forceinline__ float row16_sum(float v) {
    v += __builtin_bit_cast(float, __builtin_amdgcn_update_dpp(0, __builtin_bit_cast(int, v), 0xB1, 0xF, 0xF, true));
    v += __builtin_bit_cast(float, __builtin_amdgcn_update_dpp(0, __builtin_bit_cast(int, v), 0x4E, 0xF, 0xF, true));
    v += __builtin_bit_cast(float, __builtin_amdgcn_update_dpp(0, __builtin_bit_cast(int, v), 0x141, 0xF, 0xF, true));
    v += __builtin_bit_cast(float, __builtin_amdgcn_update_dpp(0, __builtin_bit_cast(int, v), 0x140, 0xF, 0xF, true));
    return v;
}
#undef CP_LOAD
__device__ __forceinline__ void gdn_scan_task(Frame& F, int bh, int dvh, unsigned char* ws) {
    int lane = F.lane; asm volatile("" : "+v"(lane));
    const int wv = F.wave, c = lane & 15, g = lane >> 4, b = bh / NHEAD, h = bh % NHEAD;
    const bool comp = wv < 4;
    const int dvt = 4 * dvh + (wv & 3);
    LAS unsigned char* L = F.lds + RING_OFF;
    float* GO = (float*)(ws + WS_GO);
    const unsigned char* rec0 = ws + WS_CH + (size_t)bh * GDN_NCH * CH_BYTES;
    const float* GLp = (const float*)(ws + WS_GL) + (size_t)bh * GDN_NCH;
    f32x4 S[8];
#pragma unroll
    for (int i = 0; i < 8; ++i) S[i] = (f32x4){0.f, 0.f, 0.f, 0.f};
#define SCAN_ISSUE(n_, buf_) do { const unsigned char* src_ = rec0 + (size_t)(n_) * CH_BYTES + lane * 16; \
        _Pragma("unroll") for (int i_ = 0; i_ < 14; ++i_) __builtin_amdgcn_global_load_lds((const unsigned*)(src_ + ((wv - 4) + 4 * i_) * 1024), (LAS unsigned*)(L + (buf_) * CH_LDS + ((wv - 4) + 4 * i_) * 1024), 16, 0, 0); } while (0)
#define SCAN_WARM(n_) do { const unsigned char* src_ = rec0 + (size_t)(n_) * CH_BYTES + lane * 16; \
        _Pragma("unroll") for (int i_ = 0; i_ < 28; ++i_) __builtin_amdgcn_global_load_lds((const unsigned*)(src_ + ((wv - 6) + 2 * i_) * 1024), (LAS unsigned*)(L + 2 * CH_LDS + (wv - 6) * 1024), 16, 0, 0); } while (0)
    constexpr int SCAN_PF = 4;
#define SCAN_LOADU(n_, U_) do { const GAS v2u* up_ = (const GAS v2u*)(rec0 + (size_t)(n_) * CH_BYTES + CH_UF) + (dvt * 4) * 64 + lane; \
        _Pragma("unroll") for (int tt_ = 0; tt_ < 4; ++tt_) U_[tt_] = up_[tt_ * 64]; } while (0)
    v2u U[4], Un[4]; float gl = 0.f, gln;
    const bool dmaw = (wv >= 4), warmw = false;
    if (comp) { SCAN_LOADU(0, Un); gln = GLp[0]; } else { gln = 0.f; _Pragma("unroll") for (int tt = 0; tt < 4; ++tt) Un[tt] = (v2u){0u, 0u}; }
    if (dmaw) SCAN_ISSUE(0, 0);
    if (warmw) { for (int w_ = 1; w_ <= SCAN_PF; ++w_) SCAN_WARM(w_); }
#pragma unroll
    for (int tt = 0; tt < 4; ++tt) U[tt] = Un[tt];
    const unsigned olo = (unsigned)(((4 * g) * GWID + c) * 4);
    asm volatile("s_waitcnt vmcnt(0)" ::: "memory"); __builtin_amdgcn_s_barrier(); asm volatile("" ::: "memory");
    for (int n = 0; n < GDN_NCH; ++n) {
#pragma unroll
        for (int tt = 0; tt < 4; ++tt) U[tt] = Un[tt];
        gl = gln;
        if (warmw) { if (n + 1 + SCAN_PF < GDN_NCH) SCAN_WARM(n + 1 + SCAN_PF); }
        if (dmaw && n + 1 < GDN_NCH) SCAN_ISSUE(n + 1, (n + 1) & 1);
        if (comp && n + 1 < GDN_NCH) { SCAN_LOADU(n + 1, Un); gln = GLp[n + 1]; }
        if (comp) {
            const LAS unsigned char* B = L + (n & 1) * CH_LDS + lane * 16;
            bf16x8 FA[16], FB[8];
#define LDF(dst, off) dst = *(const LAS bf16x8*)(B + (off))
#define WAITL(n_) do { asm volatile("s_waitcnt lgkmcnt(" #n_ ")" ::: "memory"); __builtin_amdgcn_sched_barrier(0); } while (0)
#pragma unroll
            for (int i = 0; i < 16; ++i) LDF(FA[i], CH_WF + i * 1024);
#pragma unroll
            for (int i = 0; i < 8; ++i) LDF(FB[i], CH_QD + i * 1024);
            bf16x8 Sb[4];
#pragma unroll
            for (int s = 0; s < 4; ++s) { v4u w; w.x = pk2c(S[2 * s][0], S[2 * s][1]); w.y = pk2c(S[2 * s][2], S[2 * s][3]); w.z = pk2c(S[2 * s + 1][0], S[2 * s + 1][1]); w.w = pk2c(S[2 * s + 1][2], S[2 * s + 1][3]);
                Sb[s] = __builtin_bit_cast(bf16x8, w); }
            WAITL(8);
            f32x4 vn[4];
#pragma unroll
            for (int tt = 0; tt < 4; ++tt) {
                f32x4 acc = {0.f, 0.f, 0.f, 0.f};
#pragma unroll
                for (int s = 0; s < 4; ++s) acc = MFMA16(FA[tt * 4 + s], Sb[s], acc);
                const v2u uu = U[tt];
                vn[tt] = (f32x4){bf_lo(uu.x) - acc[0], bf_hi(uu.x) - acc[1], bf_lo(uu.y) - acc[2], bf_hi(uu.y) - acc[3]};
            }
            __builtin_amdgcn_sched_barrier(0);
#pragma unroll
            for (int i = 0; i < 8; ++i) LDF(FA[i], CH_QD + (8 + i) * 1024);
            WAITL(8);
            f32x4 OO[4];
#pragma unroll
            for (int tt = 0; tt < 2; ++tt) {
                f32x4 acc = {0.f, 0.f, 0.f, 0.f};
#pragma unroll
                for (int s = 0; s < 4; ++s) acc = MFMA16(FB[tt * 4 + s], Sb[s], acc);
                OO[tt] = acc;
            }
            __builtin_amdgcn_sched_barrier(0);
#pragma unroll
            for (int i = 0; i < 8; ++i) LDF(FB[i], CH_QK + i * 1024);
            WAITL(8);
#pragma unroll
            for (int tt = 2; tt < 4; ++tt) {
                f32x4 acc = {0.f, 0.f, 0.f, 0.f};
#pragma unroll
                for (int s = 0; s < 4; ++s) acc = MFMA16(FA[(tt - 2) * 4 + s], Sb[s], acc);
                OO[tt] = acc;
            }
            bf16x8 Vb[2];
#pragma unroll
            for (int sp = 0; sp < 2; ++sp) { v4u w; w.x = pk2c(vn[2 * sp][0], vn[2 * sp][1]); w.y = pk2c(vn[2 * sp][2], vn[2 * sp][3]); w.z = pk2c(vn[2 * sp + 1][0], vn[2 * sp + 1][1]); w.w = pk2c(vn[2 * sp + 1][2], vn[2 * sp + 1][3]);
                Vb[sp] = __builtin_bit_cast(bf16x8, w); }
            __builtin_amdgcn_sched_barrier(0);
#pragma unroll
            for (int i = 0; i < 8; ++i) LDF(FA[8 + i], CH_KD + i * 1024);
            WAITL(8);
            GAS char* gob = (GAS char*)(GO + ((size_t)b * SEQ + (size_t)n * GDN_C) * GWID + h * HD + 16 * dvt);
#pragma unroll
            for (int tt = 0; tt < 4; ++tt) {
                f32x4 acc = OO[tt];
#pragma unroll
                for (int sp = 0; sp < 2; ++sp) acc = MFMA16(FB[tt * 2 + sp], Vb[sp], acc);
#pragma unroll
                for (int r = 0; r < 4; ++r) *(GAS float*)(gob + (size_t)((16 * tt + r) * GWID * 4) + olo) = acc[r];
            }
            __builtin_amdgcn_sched_barrier(0);
#pragma unroll
            for (int i = 0; i < 8; ++i) LDF(FB[i], CH_KD + (8 + i) * 1024);
            WAITL(8);
#pragma unroll
            for (int dkt = 0; dkt < 4; ++dkt) {
                f32x4 acc = S[dkt] * gl;
#pragma unroll
                for (int sp = 0; sp < 2; ++sp) acc = MFMA16(FA[8 + dkt * 2 + sp], Vb[sp], acc);
                S[dkt] = acc;
            }
            WAITL(0);
#pragma unroll
            for (int dkt = 4; dkt < 8; ++dkt) {
                f32x4 acc = S[dkt] * gl;
#pragma unroll
                for (int sp = 0; sp < 2; ++sp) acc = MFMA16(FB[(dkt - 4) * 2 + sp], Vb[sp], acc);
                S[dkt] = acc;
            }
#undef LDF
#undef WAITL
        }
        if (dmaw) asm volatile("s_waitcnt vmcnt(0)" ::: "memory");
        asm volatile("s_waitcnt lgkmcnt(0)" ::: "memory");
        __builtin_amdgcn_s_barrier(); asm volatile("" ::: "memory");
    }
    asm volatile("s_waitcnt vmcnt(0)" ::: "memory");
#undef SCAN_WARM
#undef SCAN_ISSUE
#undef SCAN_LOADU
}
constexpr int CW_QUEUE = 8192;
constexpr float LOG2E = 1.4426950408889634f;
constexpr int AT_KB = 16384, AT_BUF = 32768, AT_NSTAGE = 3;
constexpr int AT_KM = AT_NSTAGE * AT_BUF, AT_MISC = AT_KM + 16384;
static_assert(AT_MISC + 64 <= RING_BYTES, "attention LDS map");

__device__ __forceinline__ v4u gld16(const void* base, unsigned off) { return *(const GAS v4u*)((const GAS char*)base + off); }
__device__ __forceinline__ void gst8(void* base, unsigned off, v2u v) { *(GAS v2u*)((GAS char*)base + off) = v; }
__device__ __forceinline__ bf16x8 frag2(const LAS unsigned char* p0, const LAS unsigned char* p1) {
    const v2u a = *(const LAS v2u*)p0, b = *(const LAS v2u*)p1; v4u w; w.x = a.x; w.y = a.y; w.z = b.x; w.w = b.y; return __builtin_bit_cast(bf16x8, w);
}
__device__ __forceinline__ bf16x8 packP(const f32x4& a, const f32x4& b) { v4u w; w.x = pk2c(a[0], a[1]); w.y = pk2c(a[2], a[3]); w.z = pk2c(b[0], b[1]); w.w = pk2c(b[2], b[3]); return __builtin_bit_cast(bf16x8, w); }
__device__ __forceinline__ float grp_max(float v) {
    { auto r = __builtin_amdgcn_permlane16_swap(__float_as_uint(v), __float_as_uint(v), false, false); v = fmaxf(__uint_as_float(r[0]), __uint_as_float(r[1])); }
    { auto r = __builtin_amdgcn_permlane32_swap(__float_as_uint(v), __float_as_uint(v), false, false); v = fmaxf(__uint_as_float(r[0]), __uint_as_float(r[1])); }
    return v; }
__device__ __forceinline__ float grp_sum(float v) {
    { auto r = __builtin_amdgcn_permlane16_swap(__float_as_uint(v), __float_as_uint(v), false, false); v = __uint_as_float(r[0]) + __uint_as_float(r[1]); }
    { auto r = __builtin_amdgcn_permlane32_swap(__float_as_uint(v), __float_as_uint(v), false, false); v = __uint_as_float(r[0]) + __uint_as_float(r[1]); }
    return v; }

__device__ __forceinline__ void moba_unit(Frame& F, int b, int h, int blk, int qh, unsigned char* ws) {
    const bf16* QN = (const bf16*)(ws + WS_QN); const bf16* KN = (const bf16*)(ws + WS_KN); const bf16* VTG = (const bf16*)(ws + WS_VTG); const float* KMEAN = (const float*)(ws + WS_KMEAN);
    bf16* MIX = (bf16*)(ws + WS_MIX);
    LAS unsigned char* L = F.lds + RING_OFF;
    int tid_ = F.tid; asm volatile("" : "+v"(tid_));
    const int tid = tid_, lane = tid & 63, wv = F.wave, c = lane & 15, g = lane >> 4;
    const int bh = b * NHEAD + h;
    const int qw0 = blk * MOBA_BLK + 128 * qh + 16 * wv;
    const size_t mq0 = (size_t)b * SEQ + qw0;
    { const GAS f32x4* src = (const GAS f32x4*)(KMEAN + (size_t)bh * MOBA_NB * HD); LAS f32x4* dst = (LAS f32x4*)(L + AT_KM);
#pragma unroll
      for (int i = 0; i < 2; ++i) dst[tid + 512 * i] = src[tid + 512 * i]; }
    __syncthreads();
    unsigned selmask;
    {
        float gate[8];
#pragma unroll
        for (int nn = 0; nn < 8; ++nn) gate[nn] = 0.f;
        const bf16* qbase = QN + mq0 * GWID + h * HD; const unsigned qoff = (unsigned)c * (GWID * 2);
        const LAS float* km = (const LAS float*)(L + AT_KM) + g * HD;
        for (int dc = 0; dc < 16; ++dc) {
            const v4u w = gld16(qbase, qoff + 16 * dc);
            const float q0 = bf_lo(w.x), q1 = bf_hi(w.x), q2 = bf_lo(w.y), q3 = bf_hi(w.y), q4 = bf_lo(w.z), q5 = bf_hi(w.z), q6 = bf_lo(w.w), q7 = bf_hi(w.w);
#pragma unroll
            for (int nn = 0; nn < 8; ++nn) {
                const f32x4 ka = *(const LAS f32x4*)(km + nn * 4 * HD + 8 * dc), kb = *(const LAS f32x4*)(km + nn * 4 * HD + 8 * dc + 4);
                gate[nn] += q0 * ka.x + q1 * ka.y + q2 * ka.z + q3 * ka.w + q4 * kb.x + q5 * kb.y + q6 * kb.z + q7 * kb.w;
            }
        }
        float tv[3]; int ti[3];
#pragma unroll
        for (int t = 0; t < 3; ++t) {
            float bv = -INFINITY; int bi = -1;
#pragma unroll
            for (int nn = 0; nn < 8; ++nn) { const int n = 4 * nn + g; const float v = (n < blk) ? gate[nn] : -INFINITY; if (v > bv) { bv = v; bi = n; } }
#pragma unroll
            for (int nn = 0; nn < 8; ++nn) if (4 * nn + g == bi) gate[nn] = -INFINITY;
            tv[t] = bv; ti[t] = bi;
        }
#pragma unroll
        for (int stage = 0; stage < 2; ++stage) {
            const int xm = stage == 0 ? 16 : 32;
            float cv[6]; int cidx[6];
#pragma unroll
            for (int t = 0; t < 3; ++t) { cv[t] = tv[t]; cidx[t] = ti[t]; cv[3 + t] = __shfl_xor(tv[t], xm); cidx[3 + t] = __shfl_xor(ti[t], xm); }
#pragma unroll
            for (int t = 0; t < 3; ++t) {
                float bv = -INFINITY; int bi = -1, bs = -1;
#pragma unroll
                for (int s = 0; s < 6; ++s) { const bool better = (cv[s] > bv) || (cv[s] == bv && cv[s] > -INFINITY && cidx[s] < bi); if (better) { bv = cv[s]; bi = cidx[s]; bs = s; } }
#pragma unroll
                for (int s = 0; s < 6; ++s) if (s == bs) cv[s] = -INFINITY;
                tv[t] = bv; ti[t] = bi;
            }
        }
        unsigned msk = 0u;
#pragma unroll
        for (int t = 0; t < 3; ++t) if (ti[t] >= 0) msk |= (1u << ti[t]);
        selmask = msk;
    }
    const unsigned qmask = selmask;
    unsigned wor = selmask;
#pragma unroll
    for (int o = 1; o < 16; o <<= 1) wor |= (unsigned)__shfl_xor((int)wor, o);
    wor = (unsigned)__builtin_amdgcn_readfirstlane((int)wor);
    bf16x8 Qf[4];
#pragma unroll
    for (int ks = 0; ks < 4; ++ks) Qf[ks] = __builtin_bit_cast(bf16x8, gld16(QN + mq0 * GWID + h * HD, (unsigned)(c * (GWID * 2) + (32 * ks + 8 * g) * 2)));
    asm volatile("" : "+v"(Qf[0]), "+v"(Qf[1]), "+v"(Qf[2]), "+v"(Qf[3]));
    f32x4 O[8];
#pragma unroll
    for (int dt = 0; dt < 8; ++dt) O[dt] = (f32x4){0.f, 0.f, 0.f, 0.f};
    float lrow = 0.f;
    const float sc2 = 0.08838834764831845f * LOG2E;
    constexpr float MOBA_SHIFT2 = 8.0f * LOG2E;
#define AT_KEYBASE(t) (((t) < 4) ? (blk * MOBA_BLK + 64 * (t)) : (64 * ((t) - 4)))
    const int nown = (qh == 0) ? 2 : 4, NTE = nown + 4 * blk;
#define AT_TILE(i) (((i) < nown) ? (i) : (4 + (i) - nown))
    const unsigned ksrc0 = (unsigned)(((4 * wv + (lane >> 4)) * GWID) * 2 + (((lane & 15) ^ ((4 * wv + (lane >> 4)) & 15)) * 16));
    const unsigned ksrc1 = (unsigned)(((4 * (wv + 8) + (lane >> 4)) * GWID) * 2 + (((lane & 15) ^ ((4 * (wv + 8) + (lane >> 4)) & 15)) * 16));
    const unsigned vsrc0 = (unsigned)(((8 * wv + (lane >> 3)) * SEQ) * 2 + (((lane & 7) ^ (((8 * wv + (lane >> 3)) >> 1) & 7)) * 16));
    const unsigned vsrc1 = (unsigned)(((8 * (wv + 8) + (lane >> 3)) * SEQ) * 2 + (((lane & 7) ^ (((8 * (wv + 8) + (lane >> 3)) >> 1) & 7)) * 16));
#define AT_ISSUE(i, st) do { const int kb_ = AT_KEYBASE(AT_TILE(i)); const GAS char* kbase_ = (const GAS char*)(KN + ((size_t)b * SEQ + kb_) * GWID + h * HD); const GAS char* vbase_ = (const GAS char*)(VTG + (size_t)bh * HD * SEQ + kb_); \
        LAS unsigned char* B_ = L + (st) * AT_BUF; \
        __builtin_amdgcn_global_load_lds((const unsigned*)(kbase_ + ksrc0), (LAS unsigned*)(B_ + wv * 1024), 16, 0, 0); \
        __builtin_amdgcn_global_load_lds((const unsigned*)(kbase_ + ksrc1), (LAS unsigned*)(B_ + (wv + 8) * 1024), 16, 0, 0); \
        __builtin_amdgcn_global_load_lds((const unsigned*)(vbase_ + vsrc0), (LAS unsigned*)(B_ + AT_KB + wv * 1024), 16, 0, 0); \
        __builtin_amdgcn_global_load_lds((const unsigned*)(vbase_ + vsrc1), (LAS unsigned*)(B_ + AT_KB + (wv + 8) * 1024), 16, 0, 0); } while (0)
    const int vsw = (c >> 1) & 7;
    __syncthreads();
    AT_ISSUE(0, 0); if (NTE > 1) AT_ISSUE(1, 1);
    for (int i = 0; i < NTE; ++i) {
        if (i + 1 < NTE) asm volatile("s_waitcnt vmcnt(4)" ::: "memory"); else asm volatile("s_waitcnt vmcnt(0)" ::: "memory");
        __builtin_amdgcn_s_barrier(); asm volatile("" ::: "memory");
        if (i + 2 < NTE) AT_ISSUE(i + 2, (i + 2) % AT_NSTAGE);
        const int t = AT_TILE(i);
        const int kb = AT_KEYBASE(t);
        const int nb = kb >> 8;
        const bool own = (t < 4);
        const bool act = own ? (kb <= qw0 + 15) : (((wor >> nb) & 1u) != 0u);
        if (act) {
            const LAS unsigned char* KB = L + (i % AT_NSTAGE) * AT_BUF; const LAS unsigned char* VB = KB + AT_KB;
            f32x4 S[4];
            bf16x8 Fr[16];
            { const LAS unsigned char* kp = KB + c * 256;
#pragma unroll
              for (int kk = 0; kk < 4; ++kk)
#pragma unroll
                for (int ks = 0; ks < 4; ++ks) Fr[kk * 4 + ks] = *(const LAS bf16x8*)(kp + kk * 4096 + (((4 * ks + g) ^ c) * 16)); }
            asm volatile("s_waitcnt lgkmcnt(0)" ::: "memory"); __builtin_amdgcn_sched_barrier(0);
#pragma unroll
            for (int kk = 0; kk < 4; ++kk) { f32x4 a0 = {0.f, 0.f, 0.f, 0.f};
#pragma unroll
                for (int ks = 0; ks < 4; ++ks) a0 = MFMA16(Fr[kk * 4 + ks], Qf[ks], a0);
                S[kk] = a0; }
            { const LAS unsigned char* vp = VB + c * 128 + 8 * (g & 1);
#pragma unroll
              for (int dt = 0; dt < 8; ++dt) {
                  const LAS unsigned char* vr = vp + dt * 2048;
                  Fr[2 * dt]     = frag2(vr + ((((g >> 1)) ^ vsw) * 16),     vr + ((((g >> 1) + 2) ^ vsw) * 16));
                  Fr[2 * dt + 1] = frag2(vr + (((4 + (g >> 1)) ^ vsw) * 16), vr + (((6 + (g >> 1)) ^ vsw) * 16)); } }
            float ps = 0.f;
            if (own) { const int qpos = qw0 + c;
#pragma unroll
                for (int kk = 0; kk < 4; ++kk)
#pragma unroll
                    for (int r = 0; r < 4; ++r) { const float p = __builtin_amdgcn_exp2f(S[kk][r] * sc2 - MOBA_SHIFT2); S[kk][r] = (kb + 16 * kk + 4 * g + r > qpos) ? 0.f : p; ps += S[kk][r]; }
            } else {
                const bool sel = ((qmask >> nb) & 1u) != 0u;
#pragma unroll
                for (int kk = 0; kk < 4; ++kk)
#pragma unroll
                    for (int r = 0; r < 4; ++r) { const float p = __builtin_amdgcn_exp2f(S[kk][r] * sc2 - MOBA_SHIFT2); S[kk][r] = sel ? p : 0.f; ps += S[kk][r]; }
            }
            lrow += ps;
            const bf16x8 P0 = packP(S[0], S[1]), P1 = packP(S[2], S[3]);
            asm volatile("s_waitcnt lgkmcnt(0)" ::: "memory"); __builtin_amdgcn_sched_barrier(0);
#pragma unroll
            for (int dt = 0; dt < 8; ++dt) { O[dt] = MFMA16(Fr[2 * dt], P0, O[dt]); O[dt] = MFMA16(Fr[2 * dt + 1], P1, O[dt]); }
        }
    }
    asm volatile("s_waitcnt lgkmcnt(0)" ::: "memory");
#undef AT_TILE
#undef AT_ISSUE
#undef AT_KEYBASE
    {
        const float inv = 1.0f / grp_sum(lrow);
        bf16* obase = MIX + mq0 * D + MC_A + h * HD; const unsigned ooff = (unsigned)((c * D + 4 * g) * 2);
#pragma unroll
        for (int dt = 0; dt < 8; ++dt) { v2u o; o.x = pk2c(O[dt][0] * inv, O[dt][1] * inv); o.y = pk2c(O[dt][2] * inv, O[dt][3] * inv); gst8(obase, ooff + 32 * dt, o); }
    }
}

constexpr int SW_KP = 144, SW_VP = 528;
constexpr int SW_KB = 256 * SW_KP;
static_assert(SW_KB + 64 * SW_VP <= AT_KM, "SWA LDS map");
__device__ __forceinline__ void swa_unit(Frame& F, int b, int kvh, int nq, const float* sinks, unsigned char* ws) {
    const bf16* SQN = (const bf16*)(ws + WS_SQN); const bf16* SKN = (const bf16*)(ws + WS_SKN); const bf16* SVT = (const bf16*)(ws + WS_SVT); bf16* MIX = (bf16*)(ws + WS_MIX);
    LAS unsigned char* L = F.lds + RING_OFF;
    int tid_ = F.tid; asm volatile("" : "+v"(tid_));
    const int tid = tid_, lane = tid & 63, wv = F.wave, c = lane & 15, g = lane >> 4;
    const int hq = kvh * 8 + wv;
    const int k0 = nq * SWA_W - SWA_W;
#pragma unroll
    for (int i = 0; i < 4; ++i) {
        const int p = tid + 512 * i;
        { const int row = p >> 3, ch = p & 7; const int kp = k0 + row; v4u w = {0u, 0u, 0u, 0u};
          if (kp >= 0) w = *(const GAS v4u*)(SKN + ((size_t)b * SEQ + kp) * 128 + kvh * 64 + 8 * ch);
          *(LAS v4u*)(L + row * SW_KP + ch * 16) = w; }
        { const int row = p >> 5, ch = p & 31; const int kp = k0 + 8 * ch; v4u w = {0u, 0u, 0u, 0u};
          if (kp >= 0) w = *(const GAS v4u*)(SVT + ((size_t)(b * 2 + kvh) * 64 + row) * SEQ + kp);
          *(LAS v4u*)(L + SW_KB + row * SW_VP + ch * 16) = w; }
    }
    __syncthreads();
    const float sink = sinks[hq];
    const float sc2 = 0.125f * LOG2E;
    for (int qt = 0; qt < 8; ++qt) {
        const int qrel = 16 * qt + c;
        const size_t mqb = (size_t)b * SEQ + nq * SWA_W;
        bf16x8 Qf[2];
#pragma unroll
        for (int ks = 0; ks < 2; ++ks) Qf[ks] = __builtin_bit_cast(bf16x8, gld16(SQN + mqb * GWID + hq * 64, (unsigned)(qrel * (GWID * 2) + (32 * ks + 8 * g) * 2)));
        const int kk0 = qt & ~1;
        f32x4 S[10];
        float tmax = -INFINITY;
#pragma unroll
        for (int j = 0; j < 10; ++j) {
            f32x4 acc = {0.f, 0.f, 0.f, 0.f};
#pragma unroll
            for (int ks = 0; ks < 2; ++ks) acc = MFMA16(*(const LAS bf16x8*)(L + (16 * (kk0 + j) + c) * SW_KP + (32 * ks + 8 * g) * 2), Qf[ks], acc);
#pragma unroll
            for (int r = 0; r < 4; ++r) { const int krow = 16 * (kk0 + j) + 4 * g + r;
                const int dlt = krow - 128 - qrel;
                const bool ok = (dlt <= 0) && (dlt > -SWA_W) && (k0 + krow >= 0);
                acc[r] = ok ? acc[r] : -INFINITY; tmax = fmaxf(tmax, acc[r]); }
            S[j] = acc;
        }
        tmax = grp_max(tmax);
        const float mz = fmaxf(tmax * 0.125f, sink);
        const float mb = mz * LOG2E; float ps = 0.f;
#pragma unroll
        for (int j = 0; j < 10; ++j)
#pragma unroll
            for (int r = 0; r < 4; ++r) { const float p = __builtin_amdgcn_exp2f(S[j][r] * sc2 - mb); S[j][r] = p; ps += p; }
        const float lsum = grp_sum(ps) + __builtin_amdgcn_exp2f((sink - mz) * LOG2E);
        f32x4 O[4];
#pragma unroll
        for (int dt = 0; dt < 4; ++dt) O[dt] = (f32x4){0.f, 0.f, 0.f, 0.f};
#pragma unroll
        for (int s2 = 0; s2 < 5; ++s2) {
            const bf16x8 Pb = packP(S[2 * s2], S[2 * s2 + 1]);
#pragma unroll
            for (int dt = 0; dt < 4; ++dt) {
                const LAS unsigned char* vrow = L + SW_KB + (16 * dt + c) * SW_VP + (16 * (kk0 + 2 * s2) + 4 * g) * 2;
                O[dt] = MFMA16(frag2(vrow, vrow + 32), Pb, O[dt]);
            }
        }
        const float inv = 1.0f / lsum;
        bf16* obase = MIX + mqb * D + MC_D + hq * 64; const unsigned ooff = (unsigned)((qrel * D + 4 * g) * 2);
#pragma unroll
        for (int dt = 0; dt < 4; ++dt) { v2u o; o.x = pk2c(O[dt][0] * inv, O[dt][1] * inv); o.y = pk2c(O[dt][2] * inv, O[dt][3] * inv); gst8(obase, ooff + 32 * dt, o); }
    }
}
constexpr size_t WS_SELM = 1462 * MiB, WS_LIST = 1464 * MiB, WS_PARTL = 1472 * MiB, WS_PARTO = 1475 * MiB, WS_END5 = 1603 * MiB;
static_assert(WS_LIST + (size_t)BATCH * NHEAD * MOBA_NB * SEQ * 2 <= WS_PARTL && WS_PARTL + (size_t)BATCH * NHEAD * SEQ * 4 * 4 <= WS_PARTO && WS_PARTO + (size_t)BATCH * NHEAD * SEQ * 4 * HD * 2 <= WS_END5, "moba2 ws map");
constexpr int CW_CNT = 32768, CW_GATE = 40960;
constexpr int N_LISTS = BATCH * NHEAD * MOBA_NB;
constexpr float MOBA_SHIFT2 = 8.0f * LOG2E;
constexpr int AT_PREF = AT_MISC + 64;
static_assert(AT_PREF + 2048 + 64 <= RING_BYTES, "moba2 LDS map");

__device__ __forceinline__ void moba_gate_unit(Frame& F, int b, int h, int blk, int qh, int layer, unsigned char* ws, bool stage) {
    const bf16* QN = (const bf16*)(ws + WS_QN); const float* KMEAN = (const float*)(ws + WS_KMEAN);
    unsigned* SELM = (unsigned*)(ws + WS_SELM); unsigned short* LIST = (unsigned short*)(ws + WS_LIST);
    LAS unsigned char* L = F.lds + RING_OFF;
    int tid_ = F.tid; asm volatile("" : "+v"(tid_));
    const int tid = tid_, lane = tid & 63, wv = F.wave, c = lane & 15, g = lane >> 4;
    const int bh = b * NHEAD + h;
    const int qw0 = blk * MOBA_BLK + 128 * qh + 16 * wv;
    const size_t mq0 = (size_t)b * SEQ + qw0;
    constexpr int KMP = HD + 4;
    if (stage) {
        __syncthreads();
        const GAS f32x4* src = (const GAS f32x4*)(KMEAN + (size_t)bh * MOBA_NB * HD);
#pragma unroll
        for (int i = 0; i < 2; ++i) { const int idx = tid + 512 * i; *(LAS f32x4*)((LAS float*)L + (idx >> 5) * KMP + 4 * (idx & 31)) = src[idx]; }
        __syncthreads();
    }
    unsigned selmask;
    {
        float gate[8];
        const bf16* qbase = QN + mq0 * GWID + h * HD; const unsigned qoff = (unsigned)c * (GWID * 2) + 64u * (unsigned)g;
        v4u qw[4];
#pragma unroll
        for (int i = 0; i < 4; ++i) qw[i] = gld16(qbase, qoff + 16 * i);
        const LAS float* kmA = (const LAS float*)L + c * KMP + 32 * g;
        f32x4 ka[8], kb[8];
#pragma unroll
        for (int i = 0; i < 8; ++i) { ka[i] = *(const LAS f32x4*)(kmA + 4 * i); kb[i] = *(const LAS f32x4*)(kmA + 16 * KMP + 4 * i); }
        f32x4 accA = {0.f, 0.f, 0.f, 0.f}, accB = {0.f, 0.f, 0.f, 0.f};
#pragma unroll
        for (int kk = 0; kk < 32; ++kk) {
            const unsigned wd = qw[kk >> 3][(kk >> 1) & 3];
            const float q = (kk & 1) ? bf_hi(wd) : bf_lo(wd);
            accA = __builtin_amdgcn_mfma_f32_16x16x4f32(ka[kk >> 2][kk & 3], q, accA, 0, 0, 0);
            accB = __builtin_amdgcn_mfma_f32_16x16x4f32(kb[kk >> 2][kk & 3], q, accB, 0, 0, 0);
        }
#pragma unroll
        for (int r = 0; r < 4; ++r) { gate[r] = accA[r]; gate[4 + r] = accB[r]; }
#define GATE_BLK(nn) (((nn) < 4) ? (4 * g + (nn)) : (16 + 4 * g + (nn) - 4))
        float tv[3]; int ti[3];
#pragma unroll
        for (int t = 0; t < 3; ++t) {
            float bv = -INFINITY; int bi = -1;
#pragma unroll
            for (int nn = 0; nn < 8; ++nn) { const int n = GATE_BLK(nn); const float v = (n < blk) ? gate[nn] : -INFINITY; if (v > bv) { bv = v; bi = n; } }
#pragma unroll
            for (int nn = 0; nn < 8; ++nn) if (GATE_BLK(nn) == bi) gate[nn] = -INFINITY;
            tv[t] = bv; ti[t] = bi;
        }
#pragma unroll
        for (int stage = 0; stage < 2; ++stage) {
            const int xm = stage == 0 ? 16 : 32;
            float cv[6]; int cidx[6];
#pragma unroll
            for (int t = 0; t < 3; ++t) { cv[t] = tv[t]; cidx[t] = ti[t]; cv[3 + t] = __shfl_xor(tv[t], xm); cidx[3 + t] = __shfl_xor(ti[t], xm); }
#pragma unroll
            for (int t = 0; t < 3; ++t) {
                float bv = -INFINITY; int bi = -1, bs = -1;
#pragma unroll
                for (int s = 0; s < 6; ++s) { const bool better = (cv[s] > bv) || (cv[s] == bv && cv[s] > -INFINITY && cidx[s] < bi); if (better) { bv = cv[s]; bi = cidx[s]; bs = s; } }
#pragma unroll
                for (int s = 0; s < 6; ++s) if (s == bs) cv[s] = -INFINITY;
                tv[t] = bv; ti[t] = bi;
            }
        }
        unsigned msk = 0u;
#pragma unroll
        for (int t = 0; t < 3; ++t) if (ti[t] >= 0) msk |= (1u << ti[t]);
        selmask = msk;
    }
    const bool owner = (g == 0);
    if (owner) SELM[(size_t)bh * SEQ + qw0 + c] = selmask;
    unsigned mycnt = 0u;
#pragma unroll
    for (int n = 0; n < 32; ++n) { const unsigned long long bal = __ballot(owner && ((selmask >> n) & 1u)); const unsigned cn = (unsigned)__builtin_popcountll(bal); if (lane == n) mycnt = cn; }
    unsigned mybase = 0u;
    if (lane < 32 && mycnt > 0u) mybase = __hip_atomic_fetch_add(F.ctl + CW_CNT + layer * N_LISTS + bh * MOBA_NB + lane, mycnt, __ATOMIC_RELAXED, __HIP_MEMORY_SCOPE_AGENT);
#pragma unroll
    for (int n = 0; n < 32; ++n) {
        const bool hit = owner && ((selmask >> n) & 1u);
        const unsigned long long bal = __ballot(hit);
        if (bal != 0ull) {
            const unsigned base = (unsigned)__builtin_amdgcn_readlane((int)mybase, n);
            if (hit) { const unsigned pos = base + (unsigned)__builtin_popcountll(bal & ((1ull << lane) - 1ull));
                LIST[((size_t)bh * MOBA_NB + n) * SEQ + pos] = (unsigned short)(qw0 + c); }
        }
    }
}

struct MobaRing {
    unsigned ksrc0, ksrc1, vsrc0, vsrc1; int vsw;
    __device__ __forceinline__ void init(int lane, int wv, int c) {
        ksrc0 = (unsigned)(((4 * wv + (lane >> 4)) * GWID) * 2 + (((lane & 15) ^ ((4 * wv + (lane >> 4)) & 15)) * 16));
        ksrc1 = (unsigned)(((4 * (wv + 8) + (lane >> 4)) * GWID) * 2 + (((lane & 15) ^ ((4 * (wv + 8) + (lane >> 4)) & 15)) * 16));
        vsrc0 = (unsigned)(((8 * wv + (lane >> 3)) * SEQ) * 2 + (((lane & 7) ^ (((8 * wv + (lane >> 3)) >> 1) & 7)) * 16));
        vsrc1 = (unsigned)(((8 * (wv + 8) + (lane >> 3)) * SEQ) * 2 + (((lane & 7) ^ (((8 * (wv + 8) + (lane >> 3)) >> 1) & 7)) * 16));
        vsw = (c >> 1) & 7;
    }
};
#define MR_ISSUE(R, kbase_, vbase_, B_, wv) do { \
        __builtin_amdgcn_global_load_lds((const unsigned*)((const GAS char*)(kbase_) + (R).ksrc0), (LAS unsigned*)((B_) + (wv) * 1024), 16, 0, 0); \
        __builtin_amdgcn_global_load_lds((const unsigned*)((const GAS char*)(kbase_) + (R).ksrc1), (LAS unsigned*)((B_) + ((wv) + 8) * 1024), 16, 0, 0); \
        __builtin_amdgcn_global_load_lds((const unsigned*)((const GAS char*)(vbase_) + (R).vsrc0), (LAS unsigned*)((B_) + AT_KB + (wv) * 1024), 16, 0, 0); \
        __builtin_amdgcn_global_load_lds((const unsigned*)((const GAS char*)(vbase_) + (R).vsrc1), (LAS unsigned*)((B_) + AT_KB + ((wv) + 8) * 1024), 16, 0, 0); } while (0)
template <int MODE>
__device__ __forceinline__ void moba_tile(const LAS unsigned char* KB, const bf16x8 (&Qf)[4], f32x4 (&O)[8], float& lrow, int c, int g, int vsw, int kb, int qpos) {
    const LAS unsigned char* VB = KB + AT_KB;
    const float sc2 = 0.08838834764831845f * LOG2E;
    f32x4 S[4];
    bf16x8 Fr[16];
    { const LAS unsigned char* kp = KB + c * 256;
#pragma unroll
      for (int kk = 0; kk < 4; ++kk)
#pragma unroll
        for (int ks = 0; ks < 4; ++ks) Fr[kk * 4 + ks] = *(const LAS bf16x8*)(kp + kk * 4096 + (((4 * ks + g) ^ c) * 16)); }
    asm volatile("s_waitcnt lgkmcnt(0)" ::: "memory"); __builtin_amdgcn_sched_barrier(0);
#pragma unroll
    for (int kk = 0; kk < 4; ++kk) { f32x4 a0 = {0.f, 0.f, 0.f, 0.f};
#pragma unroll
        for (int ks = 0; ks < 4; ++ks) a0 = MFMA16(Fr[kk * 4 + ks], Qf[ks], a0);
        S[kk] = a0; }
    { const LAS unsigned char* vp = VB + c * 128 + 8 * (g & 1);
#pragma unroll
      for (int dt = 0; dt < 8; ++dt) {
          const LAS unsigned char* vr = vp + dt * 2048;
          Fr[2 * dt]     = frag2(vr + ((((g >> 1)) ^ vsw) * 16),     vr + ((((g >> 1) + 2) ^ vsw) * 16));
          Fr[2 * dt + 1] = frag2(vr + (((4 + (g >> 1)) ^ vsw) * 16), vr + (((6 + (g >> 1)) ^ vsw) * 16)); } }
    float ps = 0.f;
#pragma unroll
    for (int kk = 0; kk < 4; ++kk)
#pragma unroll
        for (int r = 0; r < 4; ++r) { float p = __builtin_amdgcn_exp2f(S[kk][r] * sc2 - MOBA_SHIFT2);
            if (MODE == 1) p = (kb + 16 * kk + 4 * g + r > qpos) ? 0.f : p;
            S[kk][r] = p; ps += p; }
    lrow += ps;
    const bf16x8 P0 = packP(S[0], S[1]), P1 = packP(S[2], S[3]);
    asm volatile("s_waitcnt lgkmcnt(0)" ::: "memory"); __builtin_amdgcn_sched_barrier(0);
#pragma unroll
    for (int dt = 0; dt < 8; ++dt) { O[dt] = MFMA16(Fr[2 * dt], P0, O[dt]); O[dt] = MFMA16(Fr[2 * dt + 1], P1, O[dt]); }
}

template <int MODE>
__device__ __forceinline__ void moba_tile2(const LAS unsigned char* KB, const bf16x8 (&Qf)[2][4], f32x4 (&O)[2][8], float (&lrow)[2], int c, int g, int vsw, int kb, int qpos0, int qpos1) {
    const LAS unsigned char* VB = KB + AT_KB;
    const float sc2 = 0.08838834764831845f * LOG2E;
    f32x4 S[2][4];
    bf16x8 F8[8];
    const LAS unsigned char* kp = KB + c * 256;
#pragma unroll
    for (int hh = 0; hh < 2; ++hh) {
#pragma unroll
        for (int kk = 0; kk < 2; ++kk)
#pragma unroll
            for (int ks = 0; ks < 4; ++ks) F8[kk * 4 + ks] = *(const LAS bf16x8*)(kp + (2 * hh + kk) * 4096 + (((4 * ks + g) ^ c) * 16));
        asm volatile("s_waitcnt lgkmcnt(0)" ::: "memory"); __builtin_amdgcn_sched_barrier(0);
#pragma unroll
        for (int kk = 0; kk < 2; ++kk) { f32x4 a0 = {0.f, 0.f, 0.f, 0.f}, a1 = {0.f, 0.f, 0.f, 0.f};
#pragma unroll
            for (int ks = 0; ks < 4; ++ks) { a0 = MFMA16(F8[kk * 4 + ks], Qf[0][ks], a0); a1 = MFMA16(F8[kk * 4 + ks], Qf[1][ks], a1); }
            S[0][2 * hh + kk] = a0; S[1][2 * hh + kk] = a1; }
        __builtin_amdgcn_sched_barrier(0);
    }
    const LAS unsigned char* vp = VB + c * 128 + 8 * (g & 1);
#pragma unroll
    for (int dt = 0; dt < 4; ++dt) {
        const LAS unsigned char* vr = vp + dt * 2048;
        F8[2 * dt]     = frag2(vr + ((((g >> 1)) ^ vsw) * 16),     vr + ((((g >> 1) + 2) ^ vsw) * 16));
        F8[2 * dt + 1] = frag2(vr + (((4 + (g >> 1)) ^ vsw) * 16), vr + (((6 + (g >> 1)) ^ vsw) * 16)); }
    bf16x8 P[2][2];
#pragma unroll
    for (int u = 0; u < 2; ++u) {
        float ps = 0.f; const int qpos = u ? qpos1 : qpos0;
#pragma unroll
        for (int kk = 0; kk < 4; ++kk)
#pragma unroll
            for (int r = 0; r < 4; ++r) { float p = __builtin_amdgcn_exp2f(S[u][kk][r] * sc2 - MOBA_SHIFT2);
                if (MODE == 1) p = (kb + 16 * kk + 4 * g + r > qpos) ? 0.f : p;
                S[u][kk][r] = p; ps += p; }
        lrow[u] += ps;
        P[u][0] = packP(S[u][0], S[u][1]); P[u][1] = packP(S[u][2], S[u][3]);
    }
    asm volatile("s_waitcnt lgkmcnt(0)" ::: "memory"); __builtin_amdgcn_sched_barrier(0);
#pragma unroll
    for (int dt = 0; dt < 4; ++dt) {
        O[0][dt] = MFMA16(F8[2 * dt], P[0][0], O[0][dt]); O[1][dt] = MFMA16(F8[2 * dt], P[1][0], O[1][dt]);
        O[0][dt] = MFMA16(F8[2 * dt + 1], P[0][1], O[0][dt]); O[1][dt] = MFMA16(F8[2 * dt + 1], P[1][1], O[1][dt]); }
    __builtin_amdgcn_sched_barrier(0);
#pragma unroll
    for (int dt = 4; dt < 8; ++dt) {
        const LAS unsigned char* vr = vp + dt * 2048;
        F8[2 * (dt - 4)]     = frag2(vr + ((((g >> 1)) ^ vsw) * 16),     vr + ((((g >> 1) + 2) ^ vsw) * 16));
        F8[2 * (dt - 4) + 1] = frag2(vr + (((4 + (g >> 1)) ^ vsw) * 16), vr + (((6 + (g >> 1)) ^ vsw) * 16)); }
    asm volatile("s_waitcnt lgkmcnt(0)" ::: "memory"); __builtin_amdgcn_sched_barrier(0);
#pragma unroll
    for (int dt = 4; dt < 8; ++dt) {
        O[0][dt] = MFMA16(F8[2 * (dt - 4)], P[0][0], O[0][dt]); O[1][dt] = MFMA16(F8[2 * (dt - 4)], P[1][0], O[1][dt]);
        O[0][dt] = MFMA16(F8[2 * (dt - 4) + 1], P[0][1], O[0][dt]); O[1][dt] = MFMA16(F8[2 * (dt - 4) + 1], P[1][1], O[1][dt]); }
}

__device__ __forceinline__ void moba_gather_unit(Frame& F, int li, int j, int cnt, unsigned char* ws) {
    const bf16* QN = (const bf16*)(ws + WS_QN); const bf16* KN = (const bf16*)(ws + WS_KN); const bf16* VTG = (const bf16*)(ws + WS_VTG);
    const unsigned* SELM = (const unsigned*)(ws + WS_SELM); const unsigned short* LIST = (const unsigned short*)(ws + WS_LIST);
    float* PARTL = (float*)(ws + WS_PARTL); bf16* PARTO = (bf16*)(ws + WS_PARTO);
    LAS unsigned char* L = F.lds + RING_OFF;
    int tid_ = F.tid; asm volatile("" : "+v"(tid_));
    const int tid = tid_, lane = tid & 63, wv = F.wave, c = lane & 15, g = lane >> 4;
    const int bh = li / MOBA_NB, n = li % MOBA_NB, b = bh / NHEAD, h = bh % NHEAD;
    MobaRing R; R.init(lane, wv, c);
    const bf16* kblk = KN + ((size_t)b * SEQ + (size_t)n * MOBA_BLK) * GWID + h * HD; const bf16* vblk = VTG + (size_t)bh * HD * SEQ + (size_t)n * MOBA_BLK;
    MR_ISSUE(R, kblk, vblk, L, wv); MR_ISSUE(R, kblk + 64 * GWID, vblk + 64, L + AT_BUF, wv);
    const int e0 = 256 * j + 32 * wv + c, e1 = e0 + 16;
    const bool valid0 = e0 < cnt, valid1 = e1 < cnt;
    const int q0 = (int)LIST[(size_t)li * SEQ + (valid0 ? e0 : 0)], q1 = (int)LIST[(size_t)li * SEQ + (valid1 ? e1 : 0)];
    const unsigned msk0 = SELM[(size_t)bh * SEQ + q0], msk1 = SELM[(size_t)bh * SEQ + q1];
    unsigned dst0 = (unsigned)q0 | ((unsigned)__builtin_popcount(msk0 & ((1u << n) - 1u)) << 16) | (valid0 ? 0x80000000u : 0u);
    unsigned dst1 = (unsigned)q1 | ((unsigned)__builtin_popcount(msk1 & ((1u << n) - 1u)) << 16) | (valid1 ? 0x80000000u : 0u);
    bf16x8 Qf[2][4];
    { const bf16* qb = QN + ((size_t)b * SEQ) * GWID + h * HD;
#pragma unroll
      for (int ks = 0; ks < 4; ++ks) { Qf[0][ks] = __builtin_bit_cast(bf16x8, gld16(qb, (unsigned)(q0 * (GWID * 2) + (32 * ks + 8 * g) * 2)));
                                        Qf[1][ks] = __builtin_bit_cast(bf16x8, gld16(qb, (unsigned)(q1 * (GWID * 2) + (32 * ks + 8 * g) * 2))); } }
    asm volatile("" : "+v"(Qf[0][0]), "+v"(Qf[0][1]), "+v"(Qf[0][2]), "+v"(Qf[0][3]), "+v"(Qf[1][0]), "+v"(Qf[1][1]), "+v"(Qf[1][2]), "+v"(Qf[1][3]), "+v"(dst0), "+v"(dst1));
    f32x4 O[2][8];
#pragma unroll
    for (int u = 0; u < 2; ++u)
#pragma unroll
        for (int dt = 0; dt < 8; ++dt) O[u][dt] = (f32x4){0.f, 0.f, 0.f, 0.f};
    float lrow[2] = {0.f, 0.f};
#pragma unroll
    for (int i = 0; i < 4; ++i) {
        if (i + 1 < 4) asm volatile("s_waitcnt vmcnt(4)" ::: "memory"); else asm volatile("s_waitcnt vmcnt(0)" ::: "memory");
        __builtin_amdgcn_s_barrier(); asm volatile("" ::: "memory");
        if (i + 2 < 4) MR_ISSUE(R, kblk + (i + 2) * 64 * GWID, vblk + (i + 2) * 64, L + ((i + 2) % AT_NSTAGE) * AT_BUF, wv);
        moba_tile2<0>(L + (i % AT_NSTAGE) * AT_BUF, Qf, O, lrow, c, g, R.vsw, 0, 0, 0);
    }
#pragma unroll
    for (int u = 0; u < 2; ++u) {
        const float lsum = grp_sum(lrow[u]);
        const unsigned dd = u ? dst1 : dst0;
        if (dd & 0x80000000u) {
            const size_t pi = ((size_t)bh * SEQ + (dd & 0xffffu)) * 4 + ((dd >> 16) & 3u);
            if (g == 0) PARTL[pi] = lsum;
            GAS char* ob = (GAS char*)(PARTO + pi * HD) + 8 * g;
#pragma unroll
            for (int dt = 0; dt < 8; ++dt) { v2u o; o.x = pk2c(O[u][dt][0], O[u][dt][1]); o.y = pk2c(O[u][dt][2], O[u][dt][3]); *(GAS v2u*)(ob + 32 * dt) = o; }
        }
    }
}

__device__ __forceinline__ void moba_own_unit(Frame& F, int b, int h, int blk, int qh, unsigned char* ws) {
    const bf16* QN = (const bf16*)(ws + WS_QN); const bf16* KN = (const bf16*)(ws + WS_KN); const bf16* VTG = (const bf16*)(ws + WS_VTG);
    float* PARTL = (float*)(ws + WS_PARTL); bf16* PARTO = (bf16*)(ws + WS_PARTO);
    LAS unsigned char* L = F.lds + RING_OFF;
    int tid_ = F.tid; asm volatile("" : "+v"(tid_));
    const int tid = tid_, lane = tid & 63, wv = F.wave, c = lane & 15, g = lane >> 4;
    const int bh = b * NHEAD + h;
    const int qw0 = blk * MOBA_BLK + 128 * qh + 16 * wv, qpos = qw0 + c;
    const size_t mq0 = (size_t)b * SEQ + qw0;
    MobaRing R; R.init(lane, wv, c);
    const int nown = (qh == 0) ? 2 : 4;
    const bf16* kblk = KN + ((size_t)b * SEQ + (size_t)blk * MOBA_BLK) * GWID + h * HD; const bf16* vblk = VTG + (size_t)bh * HD * SEQ + (size_t)blk * MOBA_BLK;
    MR_ISSUE(R, kblk, vblk, L, wv); MR_ISSUE(R, kblk + 64 * GWID, vblk + 64, L + AT_BUF, wv);
    bf16x8 Qf[4];
#pragma unroll
    for (int ks = 0; ks < 4; ++ks) Qf[ks] = __builtin_bit_cast(bf16x8, gld16(QN + mq0 * GWID + h * HD, (unsigned)(c * (GWID * 2) + (32 * ks + 8 * g) * 2)));
    asm volatile("" : "+v"(Qf[0]), "+v"(Qf[1]), "+v"(Qf[2]), "+v"(Qf[3]));
    f32x4 O[8];
#pragma unroll
    for (int dt = 0; dt < 8; ++dt) O[dt] = (f32x4){0.f, 0.f, 0.f, 0.f};
    float lrow = 0.f;
    for (int i = 0; i < nown; ++i) {
        if (i + 1 < nown) asm volatile("s_waitcnt vmcnt(4)" ::: "memory"); else asm volatile("s_waitcnt vmcnt(0)" ::: "memory");
        __builtin_amdgcn_s_barrier(); asm volatile("" ::: "memory");
        if (i + 2 < nown) MR_ISSUE(R, kblk + (i + 2) * 64 * GWID, vblk + (i + 2) * 64, L + ((i + 2) % AT_NSTAGE) * AT_BUF, wv);
        const int kb = blk * MOBA_BLK + 64 * i;
        if (kb <= qw0 + 15) moba_tile<1>(L + (i % AT_NSTAGE) * AT_BUF, Qf, O, lrow, c, g, R.vsw, kb, qpos);
    }
    const float lsum = grp_sum(lrow);
    const size_t pi = ((size_t)bh * SEQ + qpos) * 4 + 3;
    if (g == 0) PARTL[pi] = lsum;
    GAS char* ob = (GAS char*)(PARTO + pi * HD) + 8 * g;
#pragma unroll
    for (int dt = 0; dt < 8; ++dt) { v2u o; o.x = pk2c(O[dt][0], O[dt][1]); o.y = pk2c(O[dt][2], O[dt][3]); *(GAS v2u*)(ob + 32 * dt) = o; }
}

__device__ __forceinline__ void phase_moba_combine(Frame& F, unsigned char* ws) {
    const unsigned* SELM = (const unsigned*)(ws + WS_SELM); const float* PARTL = (const float*)(ws + WS_PARTL); const bf16* PARTO = (const bf16*)(ws + WS_PARTO);
    bf16* MIX = (bf16*)(ws + WS_MIX);
    int tid = F.tid; asm volatile("" : "+v"(tid));
    const int ch = tid & 15, ql = tid >> 4;
    for (int base = blockIdx.x * 64; base < BATCH * NHEAD * SEQ; base += F.G * 64) {
        v4u acc_w[2][4]; float lw[2][4]; int ns[2]; size_t idx[2];
#pragma unroll
        for (int k = 0; k < 2; ++k) {
            idx[k] = (size_t)base + 32 * k + ql;
            ns[k] = __builtin_popcount(SELM[idx[k]]);
#pragma unroll
            for (int s = 0; s < 4; ++s) { const bool ok = (s == 3) || (s < ns[k]);
                lw[k][s] = ok ? PARTL[idx[k] * 4 + s] : 0.f;
                acc_w[k][s] = ok ? *(const GAS v4u*)(PARTO + (idx[k] * 4 + s) * HD + 8 * ch) : (v4u){0u, 0u, 0u, 0u}; }
        }
#pragma unroll
        for (int k = 0; k < 2; ++k) {
            float o[8] = {0.f, 0.f, 0.f, 0.f, 0.f, 0.f, 0.f, 0.f}; float l = 0.f;
#pragma unroll
            for (int s = 0; s < 4; ++s) { float x[8]; unpack8(acc_w[k][s], x); l += lw[k][s];
#pragma unroll
                for (int e = 0; e < 8; ++e) o[e] += x[e]; }
            const float inv = 1.0f / l;
            const int bh = (int)(idx[k] / SEQ), q = (int)(idx[k] % SEQ), b = bh / NHEAD, h = bh % NHEAD;
            v4u w; w.x = pk2c(o[0] * inv, o[1] * inv); w.y = pk2c(o[2] * inv, o[3] * inv); w.z = pk2c(o[4] * inv, o[5] * inv); w.w = pk2c(o[6] * inv, o[7] * inv);
            *(GAS v4u*)(MIX + ((size_t)b * SEQ + q) * D + MC_A + h * HD + 8 * ch) = w;
        }
    }
}
#ifndef DUP_SCAN
#define DUP_SCAN 0
#endif
#ifndef DUP_QUEUE
#define DUP_QUEUE 0
#endif
constexpr int N_SWA_UNITS = BATCH * 2 * (SEQ / SWA_W), N_OWN_UNITS = BATCH * NHEAD * MOBA_NB * 2;
__device__ __forceinline__ void phase_mixers(Frame& F, const LayerW& L, unsigned char* ws, int layer, int rep) {
    constexpr int NSCAN = 2 * BATCH * NHEAD;
    const bool scanwg = blockIdx.x < NSCAN;
    gu32* gatectr = F.ctl + CW_GATE + 64 * layer;
    if (rep == 0 && !scanwg) {
        const int nwk = F.G - NSCAN, wk = blockIdx.x - NSCAN, per = (BATCH * NHEAD * MOBA_NB * 2 + nwk - 1) / nwk;
        int staged = -1;
        for (int u = wk * per; u < BATCH * NHEAD * MOBA_NB * 2 && u < (wk + 1) * per; ++u) {
            const int bh = u / (MOBA_NB * 2), r = u % (MOBA_NB * 2);
            moba_gate_unit(F, bh / NHEAD, bh % NHEAD, r >> 1, r & 1, layer, ws, staged != bh);
            staged = bh;
        }
        asm volatile("s_waitcnt vmcnt(0)" ::: "memory");
        __syncthreads();
        if (F.tid == 0) { __builtin_amdgcn_fence(__ATOMIC_RELEASE, "agent"); asm volatile("s_waitcnt vmcnt(0)" ::: "memory");
            __hip_atomic_fetch_add(gatectr, 1u, __ATOMIC_RELAXED, __HIP_MEMORY_SCOPE_AGENT); }
    }
    if (scanwg) for (int r3 = 0; r3 < (DUP_SCAN ? 2 : 1); ++r3) { gdn_scan_task(F, blockIdx.x >> 1, blockIdx.x & 1, ws); __syncthreads(); }
    LAS unsigned char* LB = F.lds + RING_OFF;
    volatile LAS unsigned* qw = (volatile LAS unsigned*)(LB + AT_MISC);
    volatile LAS unsigned* pref = (volatile LAS unsigned*)(LB + AT_PREF);
    gu32* cntp = F.ctl + CW_CNT + layer * N_LISTS;
    for (int r4 = 0; r4 < (DUP_QUEUE ? 2 : 1); ++r4) {
    gu32* head = F.ctl + CW_QUEUE + 64 * (layer * 2 + rep + 8 * r4);
#define QUEUE_FETCH(u_) do { __syncthreads();                          \
        if (F.tid == 0) *qw = __hip_atomic_fetch_add(head, 1u, __ATOMIC_RELAXED, __HIP_MEMORY_SCOPE_AGENT); \
        __syncthreads(); u_ = __builtin_amdgcn_readfirstlane((int)*qw); } while (0)
    int u; QUEUE_FETCH(u);
    while (u < N_OWN_UNITS) { const int r = u % (BATCH * NHEAD * 2), blk = MOBA_NB - 1 - u / (BATCH * NHEAD * 2), bh = r >> 1; moba_own_unit(F, bh / NHEAD, bh % NHEAD, blk, 1 - (r & 1), ws); QUEUE_FETCH(u); }
    if (F.tid == 0) {
        const unsigned want = (unsigned)(F.G - NSCAN); unsigned sp = 0u;
        while (__hip_atomic_load(gatectr, __ATOMIC_RELAXED, __HIP_MEMORY_SCOPE_AGENT) < want) { __builtin_amdgcn_s_sleep(2); if (++sp > (1u << 22)) break; }
        __builtin_amdgcn_fence(__ATOMIC_ACQUIRE, "agent"); asm volatile("s_waitcnt vmcnt(0)" ::: "memory");
    }
    __syncthreads();
    {
        const int t = F.tid; const unsigned cn = __hip_atomic_load(cntp + t, __ATOMIC_RELAXED, __HIP_MEMORY_SCOPE_AGENT);
        unsigned x = (cn + 255u) >> 8;
#pragma unroll
        for (int o = 1; o < 64; o <<= 1) { const unsigned y = (unsigned)__shfl_up((int)x, o); if (F.lane >= o) x += y; }
        if (F.lane == 63) pref[512 + F.wave] = x;
        __syncthreads();
        unsigned add = 0u;
        for (int w = 0; w < F.wave; ++w) add += pref[512 + w];
        pref[t] = x + add;
    }
    __syncthreads();
    const int total = (int)pref[511];
    while (u < N_OWN_UNITS + total + N_SWA_UNITS) {
        if (u < N_OWN_UNITS + total) {
            const int ug = u - N_OWN_UNITS;
            int lo = 0, hi = N_LISTS - 1;
            while (lo < hi) { const int mid = (lo + hi) >> 1; if ((int)pref[mid] > ug) hi = mid; else lo = mid + 1; }
            const int li = __builtin_amdgcn_readfirstlane(lo);
            const int j = ug - (li ? (int)pref[li - 1] : 0);
            const int cn = (int)__hip_atomic_load(cntp + li, __ATOMIC_RELAXED, __HIP_MEMORY_SCOPE_AGENT);
            moba_gather_unit(F, li, __builtin_amdgcn_readfirstlane(j), __builtin_amdgcn_readfirstlane(cn), ws);
        } else { const int v = u - N_OWN_UNITS - total; const int nq = v % (SEQ / SWA_W), bk = v / (SEQ / SWA_W); swa_unit(F, bk >> 1, bk & 1, nq, L.swa_sinks, ws); }
        QUEUE_FETCH(u);
    }
#undef QUEUE_FETCH
    }
}
__device__ __forceinline__ void phase_gdn_out(Frame& F, const LayerW& L, unsigned char* ws) {
    const bf16* PROJ = (const bf16*)(ws + WS_PROJ); const float* GO = (const float*)(ws + WS_GO); bf16* MIX = (bf16*)(ws + WS_MIX);
    const int gw = F.vcu * NWAVES + F.wave, NGW = F.G * NWAVES;
    int lane = F.lane; asm volatile("" : "+v"(lane));
    const float g0 = L.gdn_onorm[2 * lane], g1 = L.gdn_onorm[2 * lane + 1];
    for (int m = gw; m < M; m += NGW) {
        typedef float f32x2g __attribute__((ext_vector_type(2)));
        f32x2g o[NHEAD]; unsigned zw[NHEAD];
#pragma unroll
        for (int h = 0; h < NHEAD; ++h) { o[h] = *(const GAS f32x2g*)(GO + (size_t)m * GWID + h * HD + 2 * lane); zw[h] = *(const GAS unsigned*)(PROJ + (size_t)m * NIN + PC_GZ + h * HD + 2 * lane); }
#pragma unroll
        for (int h = 0; h < NHEAD; ++h) {
            const float r = __builtin_amdgcn_rsqf(grp_sum(row16_sum(o[h].x * o[h].x + o[h].y * o[h].y)) * (1.0f / HD) + EPS);
            const float z0 = bf_lo(zw[h]), z1 = bf_hi(zw[h]);
            *(GAS unsigned*)(MIX + (size_t)m * D + MC_B + h * HD + 2 * lane) = pk2(o[h].x * r * g0 * z0 * __builtin_amdgcn_rcpf(1.0f + __expf(-z0)), o[h].y * r * g1 * z1 * __builtin_amdgcn_rcpf(1.0f + __expf(-z1)));
        }
    }
}

#ifndef SKIP_P0
#define SKIP_P0 0
#endif
#ifndef SKIP_P1
#define SKIP_P1 0
#endif
#ifndef SKIP_P2
#define SKIP_P2 0
#endif
#ifndef SKIP_P3
#define SKIP_P3 0
#endif
#ifndef SKIP_P4
#define SKIP_P4 0
#endif
#ifndef SKIP_P5
#define SKIP_P5 0
#endif
#ifndef SKIP_P6
#define SKIP_P6 0
#endif
#ifndef SKIP_P7
#define SKIP_P7 0
#endif
#ifndef SKIP_P8
#define SKIP_P8 0
#endif
#ifndef SKIP_P9
#define SKIP_P9 0
#endif
#ifndef DUP_CHUNKPREP
#define DUP_CHUNKPREP 0
#endif
#ifndef DUP_PREPMOBA
#define DUP_PREPMOBA 0
#endif
#ifndef DUP_PREPTOK
#define DUP_PREPTOK 0
#endif
#ifndef DUP_P0
#define DUP_P0 0
#endif
#ifndef DUP_P1
#define DUP_P1 0
#endif
#ifndef DUP_P2
#define DUP_P2 0
#endif
#ifndef DUP_P3
#define DUP_P3 0
#endif
#ifndef DUP_P4
#define DUP_P4 0
#endif
#ifndef DUP_P5
#define DUP_P5 0
#endif
#ifndef DUP_P6
#define DUP_P6 0
#endif
#ifndef DUP_P7
#define DUP_P7 0
#endif
#ifndef DUP_P8
#define DUP_P8 0
#endif
#ifndef DUP_P9
#define DUP_P9 0
#endif
struct Args { const float* in[18]; float* out; unsigned char* ws; int ph_lo, ph_hi, li, pad; };
constexpr int PH_PER_LAYER = 9, N_PHASES = DEPTH * PH_PER_LAYER;
#ifndef MK_N_LAUNCHES
#define MK_N_LAUNCHES 1
#endif

__global__ void __launch_bounds__(NWAVES * 64, 2) hymba_fwd(Args args) {
    extern __shared__ __attribute__((aligned(16))) unsigned char lds[];
    Frame F;
    F.lds = (LAS unsigned char*)lds;
    F.MISC = (volatile LAS unsigned*)(F.lds + MISC_OFF);
    F.tid = threadIdx.x; F.lane = F.tid & 63; F.wave = __builtin_amdgcn_readfirstlane(F.tid >> 6);
    F.G = gridDim.x; { const int bx = blockIdx.x; F.vcu = (F.G % 8 == 0) ? (bx % 8) * (F.G / 8) + bx / 8 : bx; }
    F.ctl = (gu32*)(args.ws + WS_CTL);
    for (int u = F.tid; u < (LDS_BYTES - LDSCTL_OFF) / 4; u += NWAVES * 64) ((LAS unsigned*)(F.lds + LDSCTL_OFF))[u] = 0u;
    __syncthreads();
    XcdBarrier bar = xcd_barrier_post((unsigned*)(F.ctl + CW_BAR) + args.li * XCD_BAR_WORDS, F.MISC + 8);
    const int lo = args.ph_lo, hi = args.ph_hi;
#define IN(k) (lo <= (k) && (k) < hi)
#define SEAM(k) do { if (IN(k) && IN((k) + 1)) xcd_barrier(bar); } while (0)

    typedef const __attribute__((address_space(4))) Args* KArgs;
#define PHASE_BEGIN() do { int t_ = threadIdx.x; asm volatile("" : "+v"(t_)); F.tid = t_; F.lane = t_ & 63; F.wave = __builtin_amdgcn_readfirstlane(t_ >> 6); F.G = gridDim.x; \
        { const int bx_ = blockIdx.x; F.vcu = (F.G % 8 == 0) ? (bx_ % 8) * (F.G / 8) + bx_ / 8 : bx_; } } while (0)
#define KA() ({ PHASE_BEGIN(); KArgs _p = (KArgs)__builtin_amdgcn_kernarg_segment_ptr(); asm volatile("" : "+s"(_p)); _p; })
#define MAKE_L(L, ap, layer) LayerW L; { \
        L.norm_mix = ap->in[1] + (size_t)layer * D; L.w_in = ap->in[2] + (size_t)layer * D * IN_REAL; L.moba_qn = ap->in[3] + layer * HD; L.moba_kn = ap->in[4] + layer * HD; \
        L.gdn_conv = ap->in[5] + (size_t)layer * 4 * 3 * GWID; L.gdn_alog = ap->in[6] + layer * NHEAD; L.gdn_dtb = ap->in[7] + layer * NHEAD; L.gdn_onorm = ap->in[8] + layer * HD; \
        L.sc_conv = ap->in[9] + (size_t)layer * 3 * GWID; L.swa_qn = ap->in[10] + layer * 64; L.swa_kn = ap->in[11] + layer * 64; L.swa_sinks = ap->in[12] + layer * 16; \
        L.w_out = ap->in[13] + (size_t)layer * D * D; L.norm_ffn = ap->in[14] + (size_t)layer * D; L.w_gate = ap->in[15] + (size_t)layer * D * DFF; L.w_up = ap->in[16] + (size_t)layer * D * DFF; \
        L.w_down = ap->in[17] + (size_t)layer * DFF * D; }
    for (int layer = 0; layer < DEPTH; ++layer) {
        const int pb = layer * PH_PER_LAYER;
        for (int rep = 0; rep < (DUP_P0 ? 2 : 1); ++rep) {
        if (IN(pb + 0)) if (!SKIP_P0) { KArgs ap = KA(); unsigned char* ws = ap->ws; MAKE_L(L, ap, layer);
            phase_convert_weights(F, L, ws);
            if (layer == 0) phase_rmsnorm(F, ap->in[0], L.norm_mix, (bf16*)(ws + WS_H), (float*)(ws + WS_RSTD)); else phase_rstd(F, (const float*)(ws + WS_RS), (float*)(ws + WS_RSTD)); }
        SEAM(pb + 0);
        }
        for (int rep = 0; rep < (DUP_P1 ? 2 : 1); ++rep) {
        if (IN(pb + 1)) if (!SKIP_P1) { KArgs ap = KA(); unsigned char* ws = ap->ws;
            pg8::Gemm g{(const bf16*)(ws + WS_H), (const bf16*)(ws + WS_WIN), M, NIN, D}; pg8::StaticOrder S; S.init(M, NIN, F.G, (int)blockIdx.x);
            pg8::EpiBf16Plain E{(bf16*)(ws + WS_PROJ), NIN, (const float*)(ws + WS_RSTD)};
            pg8::gemm_phase<pg8::EpiBf16Plain, pg8::StaticOrder, true, true>(F.lds + RING_OFF, g, S, E); }
        SEAM(pb + 1);
        }
        for (int rep = 0; rep < (DUP_P2 ? 2 : 1); ++rep) {
        if (IN(pb + 2)) if (!SKIP_P2) { KArgs ap = KA(); unsigned char* ws = ap->ws; MAKE_L(L, ap, layer); for (int r2 = 0; r2 < (DUP_PREPMOBA ? 2 : 1); ++r2) { phase_prep_moba(F, L, ws); __syncthreads(); } for (int r2 = 0; r2 < (DUP_PREPTOK ? 2 : 1); ++r2) { phase_prep_tokens(F, L, ws); __syncthreads(); } for (int r2 = 0; r2 < (DUP_CHUNKPREP ? 2 : 1); ++r2) { phase_gdn_chunk_prep(F, ws, L.gdn_conv, L.gdn_alog, L.gdn_dtb); __syncthreads(); } }
        SEAM(pb + 2);
        }
        for (int rep = 0; rep < (DUP_P3 ? 2 : 1); ++rep) {
        if (IN(pb + 3)) if (!SKIP_P3) { KArgs ap = KA(); unsigned char* ws = ap->ws; MAKE_L(L, ap, layer); phase_mixers(F, L, ws, layer, rep); }
        SEAM(pb + 3);
        }
        for (int rep = 0; rep < (DUP_P4 ? 2 : 1); ++rep) {
        if (IN(pb + 4)) if (!SKIP_P4) { KArgs ap = KA(); unsigned char* ws = ap->ws; MAKE_L(L, ap, layer); phase_moba_combine(F, ws); phase_gdn_out(F, L, ws); }
        SEAM(pb + 4);
        }
        for (int rep = 0; rep < (DUP_P5 ? 2 : 1); ++rep) {
        if (IN(pb + 5)) if (!SKIP_P5) { KArgs ap = KA(); unsigned char* ws = ap->ws;
            pg8::Gemm g{(const bf16*)(ws + WS_MIX), (const bf16*)(ws + WS_WOUT), M, D, D}; pg8::StaticOrder S; S.init(M, D, F.G, (int)blockIdx.x);
            pg8::EpiResF32 E{(layer == 0) ? ap->in[0] : ap->out, ap->out, D, (bf16*)(ws + WS_H), ap->in[14] + (size_t)layer * D, (float*)(ws + WS_RS)};
            pg8::gemm_phase<pg8::EpiResF32, pg8::StaticOrder, true, true>(F.lds + RING_OFF, g, S, E); }
        SEAM(pb + 5);
        }
        for (int rep = 0; rep < (DUP_P6 ? 2 : 1); ++rep) {
        if (IN(pb + 6)) if (!SKIP_P6) { KArgs ap = KA(); unsigned char* ws = ap->ws; phase_rstd(F, (const float*)(ws + WS_RS), (float*)(ws + WS_RSTD)); }
        SEAM(pb + 6);
        }
        for (int rep = 0; rep < (DUP_P7 ? 2 : 1); ++rep) {
        if (IN(pb + 7)) if (!SKIP_P7) { KArgs ap = KA(); unsigned char* ws = ap->ws;
            pg8::Gemm g{(const bf16*)(ws + WS_H), (const bf16*)(ws + WS_WGU), M, NGU, D}; pg8::StaticOrder S; S.init(M, NGU, F.G, (int)blockIdx.x);
            pg8::EpiSwiGLU E{(bf16*)(ws + WS_ACT), DFF, (const float*)(ws + WS_RSTD)};
            pg8::gemm_phase<pg8::EpiSwiGLU, pg8::StaticOrder, true, true>(F.lds + RING_OFF, g, S, E); }
        SEAM(pb + 7);
        }
        for (int rep = 0; rep < (DUP_P8 ? 2 : 1); ++rep) {
        if (IN(pb + 8)) if (!SKIP_P8) { KArgs ap = KA(); unsigned char* ws = ap->ws;
            pg8::Gemm g{(const bf16*)(ws + WS_ACT), (const bf16*)(ws + WS_WDN), M, D, DFF}; pg8::StaticOrder S; S.init(M, D, F.G, (int)blockIdx.x, 2);
            pg8::EpiResF32 E{ap->out, ap->out, D, (layer + 1 < DEPTH) ? (bf16*)(ws + WS_H) : (bf16*)nullptr, ap->in[1] + (size_t)(layer + 1 < DEPTH ? layer + 1 : layer) * D, (float*)(ws + WS_RS)};
            pg8::gemm_phase<pg8::EpiResF32, pg8::StaticOrder, true, true>(F.lds + RING_OFF, g, S, E); }
        SEAM(pb + 8);
        }
    }
#undef IN
#undef SEAM
}

extern "C" void kernel_launch(void* const* d_in, const int* in_sizes, int n_in, void* d_out, int out_size, void* d_ws, size_t ws_size, hipStream_t stream) {
    static int grid = 0;
    if (grid == 0) {
        if (n_in != 18 || in_sizes[0] != M * D || out_size != M * D || ws_size < WS_END5) { fprintf(stderr, "kernel_launch: unexpected shapes (n_in %d, in0 %d, out %d, ws %zu); nothing launched\n", n_in, n_in > 0 ? in_sizes[0] : -1, out_size, ws_size); grid = -1; return; }
        int dev = 0, cus = 0, per_cu = 0;
        if (hipGetDevice(&dev) != hipSuccess || hipDeviceGetAttribute(&cus, hipDeviceAttributeMultiprocessorCount, dev) != hipSuccess) { grid = -1; return; }
        if (hipFuncSetAttribute((const void*)hymba_fwd, hipFuncAttributeMaxDynamicSharedMemorySize, LDS_BYTES) != hipSuccess) { fprintf(stderr, "kernel_launch: hipFuncSetAttribute failed\n"); grid = -1; return; }
        if (hipOccupancyMaxActiveBlocksPerMultiprocessor(&per_cu, (const void*)hymba_fwd, NWAVES * 64, LDS_BYTES) != hipSuccess || per_cu < 1)
            fprintf(stderr, "kernel_launch: note: occupancy query reports %d workgroups per CU\n", per_cu);
        (void)hipGetLastError();
        grid = cus;
    }
    if (grid < 0) return;
    if (hipMemsetAsync((char*)d_ws + WS_CTL, 0, CTL_ZERO_BYTES, stream) != hipSuccess) return;
    Args a{};
    for (int i = 0; i < 18; ++i) a.in[i] = (const float*)d_in[i];
    a.out = (float*)d_out; a.ws = (unsigned char*)d_ws; a.pad = 0;
#if MK_N_LAUNCHES == 1
    a.ph_lo = 0; a.ph_hi = N_PHASES; a.li = 0;
    hipLaunchKernelGGL(hymba_fwd, dim3(grid), dim3(NWAVES * 64), LDS_BYTES, stream, a);
#else
    for (int p = 0; p < N_PHASES; ++p) { a.ph_lo = p; a.ph_hi = p + 1; a.li = 0;
        hipLaunchKernelGGL(hymba_fwd, dim3(grid), dim3(NWAVES * 64), LDS_BYTES, stream, a); }
#endif
}
```
